# Optimizing an MI355X kernel written in HIP

```python
import math
import jax, jax.numpy as jnp
from jax import lax
import numpy as np

D_MODEL = 1024
BATCH = 2
SEQ = 8192
DEPTH = 1

N_HEADS_A = 8
HEAD_DIM_A = 64
D_LATENT = 256
N_HEADS_IDX = 8
HEAD_DIM_IDX = 64
TOPK_MAX = 256
Q_BLOCK = 128
N_BUCKETS = 32
MAX_DISTANCE = 128
N_HEADS_M = 4
HEAD_DIM_M = 128
CHUNK = 64
CONV_WIDTH = 4
F_BIAS_INIT = 3.0
D_FF = 2816
EPS = 1e-6

W_A = N_HEADS_A * HEAD_DIM_A
W_M = N_HEADS_M * HEAD_DIM_M
IDX_SCALE = (N_HEADS_IDX ** -0.5) * (HEAD_DIM_IDX ** -0.5)
SPLITS = (W_A, D_LATENT, N_HEADS_IDX * HEAD_DIM_IDX, HEAD_DIM_IDX, N_HEADS_IDX,
          W_M, W_M, W_M, N_HEADS_M, N_HEADS_M, W_M, D_MODEL, D_MODEL)
D_IN = sum(SPLITS)

kernel_name = "hybrid_dsa_mlstm_macaron_block"


def rms_norm(x, g):
    xf = x.astype(jnp.float32)
    y = xf * lax.rsqrt(jnp.mean(xf * xf, axis=-1, keepdims=True) + EPS)
    return (y * g.astype(jnp.float32)).astype(x.dtype)


def modulate(h, shift, scale):
    return h * (1.0 + scale[:, None, :]) + shift[:, None, :]


def swiglu(h, w1, w3, w2):
    return (jax.nn.silu(h @ w1) * (h @ w3)) @ w2


def t5_bucket(dist):
    n = jnp.maximum(dist, 0)
    max_exact = N_BUCKETS // 2
    nf = jnp.maximum(n, 1).astype(jnp.float32)
    large = max_exact + (jnp.log(nf / max_exact) / math.log(MAX_DISTANCE / max_exact)
                         * (N_BUCKETS - max_exact)).astype(jnp.int32)
    large = jnp.minimum(large, N_BUCKETS - 1)
    return jnp.where(n < max_exact, n, large)


def dsa_attention(q, c_kv, q_idx, k_idx, w_idx, w_uk, w_uv, rel_bias):
    B, S = q.shape[:2]
    nb = S // Q_BLOCK
    topk = min(TOPK_MAX, S // 4)
    kpos = jnp.arange(S)
    scale = HEAD_DIM_A ** -0.5

    def blocks(a):
        return jnp.moveaxis(a.reshape(B, nb, Q_BLOCK, *a.shape[2:]), 1, 0)

    def one_block(args):
        blk, qb, qib, wb = args
        tpos = blk * Q_BLOCK + jnp.arange(Q_BLOCK)
        idx_logits = jax.nn.relu(jnp.einsum('bthd,bsd->bths', qib, k_idx).astype(jnp.float32))
        score = jnp.einsum('bth,bths->bts', wb.astype(jnp.float32), idx_logits)
        causal = kpos[None, :] <= tpos[:, None]
        score = jnp.where(causal[None], score, -jnp.inf)
        _, sel = lax.top_k(score, topk)
        ckv_sel = jax.vmap(lambda cb, ib: cb[ib])(c_kv, sel)
        q_abs = jnp.einsum('bthd,hcd->bthc', qb, w_uk)
        logits = jnp.einsum('bthc,btkc->bthk', q_abs, ckv_sel).astype(jnp.float32) * scale
        dist = tpos[None, :, None] - sel
        bias = jnp.moveaxis(rel_bias[t5_bucket(dist)], -1, 2)
        logits = logits + bias.astype(jnp.float32)
        logits = jnp.where((dist >= 0)[:, :, None, :], logits, -jnp.inf)
        p = jax.nn.softmax(logits, axis=-1).astype(ckv_sel.dtype)
        o_lat = jnp.einsum('bthk,btkc->bthc', p, ckv_sel)
        return jnp.einsum('bthc,hcd->bthd', o_lat, w_uv)

    out = lax.map(one_block, (jnp.arange(nb), blocks(q), blocks(q_idx), blocks(w_idx)))
    return jnp.moveaxis(out, 0, 1).reshape(B, S, W_A)


def mlstm_chunkwise(q, k, v, i_pre, logf):
    B, H, S, dk = q.shape
    dv = v.shape[-1]
    nc = S // CHUNK
    tri = jnp.tril(jnp.ones((CHUNK, CHUNK), dtype=bool))

    def to_chunks(a):
        return jnp.moveaxis(a.reshape(B, H, nc, CHUNK, *a.shape[3:]), 2, 0)

    def step(carry, inp):
        C, n, m = carry
        qc, kc, vc, ic, fc = inp
        b = jnp.cumsum(fc, axis=-1)
        d_log = jnp.where(tri, b[..., :, None] - b[..., None, :] + ic[..., None, :], -jnp.inf)
        inter_log = b + m[..., None]
        m_j = jnp.maximum(inter_log, jnp.max(d_log, axis=-1))
        s = jnp.einsum('bhjd,bhsd->bhjs', qc, kc) * jnp.exp(d_log - m_j[..., None])
        w_inter = jnp.exp(inter_log - m_j)
        num = (w_inter[..., None] * jnp.einsum('bhjd,bhde->bhje', qc, C)
               + jnp.einsum('bhjs,bhse->bhje', s, vc))
        den = w_inter * jnp.einsum('bhjd,bhd->bhj', qc, n) + jnp.sum(s, axis=-1)
        h = num / jnp.maximum(jnp.abs(den), jnp.exp(-m_j))[..., None]
        b_last = b[..., -1]
        g = b_last[..., None] - b + ic
        m_new = jnp.maximum(b_last + m, jnp.max(g, axis=-1))
        w = jnp.exp(g - m_new[..., None])
        decay = jnp.exp(b_last + m - m_new)
        C_new = decay[..., None, None] * C + jnp.einsum('bhs,bhsd,bhse->bhde', w, kc, vc)
        n_new = decay[..., None] * n + jnp.einsum('bhs,bhsd->bhd', w, kc)
        return (C_new, n_new, m_new), h

    init = (jnp.zeros((B, H, dk, dv), jnp.float32), jnp.zeros((B, H, dk), jnp.float32),
            jnp.zeros((B, H), jnp.float32))
    _, hs = lax.scan(step, init, (to_chunks(q), to_chunks(k), to_chunks(v),
                                  to_chunks(i_pre), to_chunks(logf)))
    return jnp.moveaxis(hs, 0, 2).reshape(B, H, S, dv)


def causal_conv(x, w, b):
    C = x.shape[-1]
    y = lax.conv_general_dilated(x, w[:, None, :].astype(x.dtype), window_strides=(1,),
                                 padding=[(CONV_WIDTH - 1, 0)],
                                 dimension_numbers=('NWC', 'WIO', 'NWC'),
                                 feature_group_count=C)
    return y + b


def hybrid_mixer(h, w_in, conv_w, conv_b, kv_norm, w_uk, w_uv, gate_bias, head_norm,
                 rel_bias, w_branch_attn, w_branch_mlstm, w_out):
    B, S, _ = h.shape
    split_points = np.cumsum(SPLITS)[:-1].tolist()
    (q_a, c_kv, q_idx, k_idx, w_idx, q_m, k_m, v_m, i_pre, f_pre, o_pre,
     gate_a, gate_m) = jnp.split(h @ w_in, split_points, axis=-1)

    c_kv = rms_norm(c_kv, kv_norm)
    y_a = dsa_attention(q_a.reshape(B, S, N_HEADS_A, HEAD_DIM_A), c_kv,
                        q_idx.reshape(B, S, N_HEADS_IDX, HEAD_DIM_IDX), k_idx,
                        w_idx * IDX_SCALE, w_uk, w_uv, rel_bias)

    qk = jax.nn.silu(causal_conv(jnp.concatenate([q_m, k_m], axis=-1), conv_w, conv_b))
    q_m, k_m = jnp.split(qk, 2, axis=-1)

    def heads(a):
        return a.reshape(B, S, N_HEADS_M, -1).transpose(0, 2, 1, 3).astype(jnp.float32)

    i_g = (i_pre + gate_bias[:N_HEADS_M]).astype(jnp.float32).transpose(0, 2, 1)
    logf = jax.nn.log_sigmoid((f_pre + gate_bias[N_HEADS_M:]).astype(jnp.float32)).transpose(0, 2, 1)
    h_m = mlstm_chunkwise(heads(q_m), heads(k_m) * (HEAD_DIM_M ** -0.5), heads(v_m), i_g, logf)
    mu = jnp.mean(h_m, axis=-1, keepdims=True)
    var = jnp.mean(jnp.square(h_m - mu), axis=-1, keepdims=True)
    h_m = (h_m - mu) * lax.rsqrt(var + EPS)
    h_m = h_m.transpose(0, 2, 1, 3).reshape(B, S, W_M) * head_norm.astype(jnp.float32)
    h_m = h_m.astype(h.dtype) * jax.nn.sigmoid(o_pre)

    merged = (jax.nn.sigmoid(gate_a) * (y_a @ w_branch_attn)
              + jax.nn.sigmoid(gate_m) * (h_m @ w_branch_mlstm))
    return merged @ w_out


def setup_inputs(seed: int = 0) -> dict:
    key = jax.random.key(seed)
    ks = iter(jax.random.split(key, 40))
    nrm = lambda shape, s: jax.random.normal(next(ks), shape, jnp.float32) * s
    gain = lambda shape: 1.0 + nrm(shape, 0.05)
    L = DEPTH
    gate_bias = jnp.concatenate([nrm((L, N_HEADS_M), 0.1),
                                 F_BIAS_INIT + nrm((L, N_HEADS_M), 0.5)], axis=-1)
    return {
        "x": nrm((BATCH, SEQ, D_MODEL), 1.0),
        "c": nrm((BATCH, D_MODEL), 1.0),
        "ada_w": nrm((L, D_MODEL, 9 * D_MODEL), 0.5 * D_MODEL ** -0.5),
        "ada_b": nrm((L, 9 * D_MODEL), 0.01),
        "ffn1_norm": gain((L, D_MODEL)),
        "ffn1_w1": nrm((L, D_MODEL, D_FF), D_MODEL ** -0.5),
        "ffn1_w3": nrm((L, D_MODEL, D_FF), D_MODEL ** -0.5),
        "ffn1_w2": nrm((L, D_FF, D_MODEL), D_FF ** -0.5),
        "mix_norm": gain((L, D_MODEL)),
        "w_in": nrm((L, D_MODEL, D_IN), D_MODEL ** -0.5),
        "conv_w": nrm((L, CONV_WIDTH, 2 * W_M), CONV_WIDTH ** -0.5),
        "conv_b": nrm((L, 2 * W_M), 0.01),
        "kv_norm": gain((L, D_LATENT)),
        "w_uk": nrm((L, N_HEADS_A, D_LATENT, HEAD_DIM_A), D_LATENT ** -0.5),
        "w_uv": nrm((L, N_HEADS_A, D_LATENT, HEAD_DIM_A), D_LATENT ** -0.5),
        "mlstm_gate_bias": gate_bias,
        "mlstm_head_norm": gain((L, W_M)),
        "rel_bias": nrm((N_BUCKETS, N_HEADS_A), 0.5),
        "w_branch_attn": nrm((L, W_A, D_MODEL), W_A ** -0.5),
        "w_branch_mlstm": nrm((L, W_M, D_MODEL), W_M ** -0.5),
        "w_out": nrm((L, D_MODEL, D_MODEL), D_MODEL ** -0.5),
        "ffn2_norm": gain((L, D_MODEL)),
        "ffn2_w1": nrm((L, D_MODEL, D_FF), D_MODEL ** -0.5),
        "ffn2_w3": nrm((L, D_MODEL, D_FF), D_MODEL ** -0.5),
        "ffn2_w2": nrm((L, D_FF, D_MODEL), D_FF ** -0.5),
        "final_norm": gain((D_MODEL,)),
    }


def reference(x, c, ada_w, ada_b, ffn1_norm, ffn1_w1, ffn1_w3, ffn1_w2, mix_norm, w_in,
              conv_w, conv_b, kv_norm, w_uk, w_uv, mlstm_gate_bias, mlstm_head_norm,
              rel_bias, w_branch_attn, w_branch_mlstm, w_out, ffn2_norm, ffn2_w1, ffn2_w3,
              ffn2_w2, final_norm):
    cond = jax.nn.silu(c)
    for l in range(DEPTH):
        mod = cond @ ada_w[l] + ada_b[l]
        sh1, sc1, g1, sh2, sc2, g2, sh3, sc3, g3 = jnp.split(mod, 9, axis=-1)
        h = modulate(rms_norm(x, ffn1_norm[l]), sh1, sc1)
        x = x + 0.5 * g1[:, None, :] * swiglu(h, ffn1_w1[l], ffn1_w3[l], ffn1_w2[l])
        h = modulate(rms_norm(x, mix_norm[l]), sh2, sc2)
        x = x + g2[:, None, :] * hybrid_mixer(h, w_in[l], conv_w[l], conv_b[l], kv_norm[l],
                                              w_uk[l], w_uv[l], mlstm_gate_bias[l],
                                              mlstm_head_norm[l], rel_bias, w_branch_attn[l],
                                              w_branch_mlstm[l], w_out[l])
        h = modulate(rms_norm(x, ffn2_norm[l]), sh3, sc3)
        x = x + 0.5 * g3[:, None, :] * swiglu(h, ffn2_w1[l], ffn2_w3[l], ffn2_w2[l])
    return rms_norm(x, final_norm)
```

```cpp
#include <hip/hip_runtime.h>
#include <cstdio>
#include <cstdint>
#include <cmath>
typedef _Float16 h16;
typedef _Float16 half8 __attribute__((ext_vector_type(8)));
typedef _Float16 half4 __attribute__((ext_vector_type(4)));
namespace pg8 {
typedef _Float16 half8 __attribute__((ext_vector_type(8)));
#define PG8_LAS __attribute__((address_space(3)))
typedef unsigned short bf16_t;
typedef short bf16x8 __attribute__((ext_vector_type(8)));
typedef float f32x4 __attribute__((ext_vector_type(4)));
typedef unsigned u32x4 __attribute__((ext_vector_type(4)));
constexpr int BM = 256, BK = 64, HALF = 128, HTB = HALF * BK * 2  , STAGE_BYTES = 8 * HTB, NXCD = 8, WGM = 8;

__host__ __device__ __forceinline__ int lds_byte(int r, int c) { const int st = (r >> 4) * 2 + (c >> 5), rr = r & 15, cc = c & 31, ob = rr * 64 + cc * 2; return st * 1024 + (ob ^ (((ob >> 9) & 1) << 5)); }
__host__ __device__ __forceinline__ void stage_rc(int b, int& R, int& C) { const int st = b / 1024, sb = b % 1024, swz = sb ^ (((sb >> 9) & 1) << 5); R = (st >> 1) * 16 + swz / 64; C = (st & 1) * 32 + (swz % 64) / 2; }
__host__ __device__ __forceinline__ int perm32(int rho) { const int n = rho >> 4, i = rho & 15; return 8 * (i >> 2) + 4 * n + (i & 3); }

struct Unit { int pm, pn; };
struct Gemm { const bf16_t* A; const bf16_t* Bt; int M, N, K; };

struct StaticOrder {
    int nM, nN, nwg, G, c;
    __host__ __device__ void init(int M, int N, int G_, int c_) { nM = M / BM; nN = N / BM; nwg = nM * nN; G = G_; c = c_; }
    __host__ __device__ bool next(int i, Unit& u) const {
        const long L = (long)i * G + c; if (L >= nwg) return false;
        int wgid = (int)L; { const int q = nwg / NXCD, r = nwg % NXCD, xcd = wgid % NXCD, off = wgid / NXCD; wgid = (xcd < r ? xcd * (q + 1) : r * (q + 1) + (xcd - r) * q) + off; }
        const int nig = WGM * nN, gid = wgid / nig, fm = gid * WGM, gsz = (nM - fm) < WGM ? (nM - fm) : WGM;
        u.pm = fm + ((wgid % nig) % gsz); u.pn = (wgid % nig) / gsz; return true;
    }
    __device__ __forceinline__ void a_ready(const Unit&) const {}
    __device__ __forceinline__ void done(const Unit&) const {}
};
template <class Epi, class Sched, bool ALIGN_EPI = false, bool SP2 = false>
__device__ __forceinline__ void gemm_phase(PG8_LAS unsigned char* lds, const Gemm g, const Sched& S, const Epi& E) {
    const int tid = threadIdx.x, wid = __builtin_amdgcn_readfirstlane(tid >> 6), lane = tid & 63, wr = wid >> 2, wc = wid & 3, fr = lane & 15, fq = lane >> 4;
    const int K = g.K, nt = K / BK;
    unsigned voffA[2], voffB[2];
#pragma unroll
    for (int i = 0; i < 2; ++i) { int R, C; stage_rc(tid * 16 + i * 8192, R, C); const int Rb = Epi::PERM ? ((R & ~31) + perm32(R & 31)) : R;
        voffA[i] = (unsigned)(R * K + C) * 2u; voffB[i] = (unsigned)(Rb * K + C) * 2u; }
    const size_t kstep = (size_t)(BK * 2);
    const size_t hstep = (size_t)HALF * K * 2;
    const size_t tstep = 2 * hstep;
    const unsigned ldsw = (unsigned)wid * 1024u;
    const int aoff = lds_byte(wr * 64 + fr, fq * 8), boff = lds_byte(wc * 32 + fr, fq * 8);
#define PG8_SA(b, h) (((b) * 2 + (h)) * HTB)
#define PG8_SB(b, h) ((4 + (b) * 2 + (h)) * HTB)
#define PG8_STAGE(bufoff, gbase, voff) do { _Pragma("unroll") for (int _i = 0; _i < 2; ++_i) \
        __builtin_amdgcn_global_load_lds((const unsigned*)((const char*)(gbase) + (voff)[_i]), (PG8_LAS unsigned*)(lds + (bufoff) + ldsw + _i * 8192), 16, 0, 0); } while (0)
#define PG8_LDA(dst, b, h) do { _Pragma("unroll") for (int m = 0; m < 4; ++m) _Pragma("unroll") for (int k = 0; k < 2; ++k) dst[m][k] = *(const PG8_LAS bf16x8*)(lds + PG8_SA(b, h) + aoff + m * 2048 + k * 1024); } while (0)
#define PG8_LDB(dst, b, h) do { _Pragma("unroll") for (int n = 0; n < 2; ++n) _Pragma("unroll") for (int k = 0; k < 2; ++k) dst[n][k] = *(const PG8_LAS bf16x8*)(lds + PG8_SB(b, h) + boff + n * 2048 + k * 1024); } while (0)
#define PG8_MMA(ai, bj, At, Bt) do { __builtin_amdgcn_s_setprio(1); _Pragma("unroll") for (int m = 0; m < 4; ++m) _Pragma("unroll") for (int n = 0; n < 2; ++n) _Pragma("unroll") for (int k = 0; k < 2; ++k) \
        acc[ai][bj][m][n] = __builtin_amdgcn_mfma_f32_16x16x32_f16(__builtin_bit_cast(half8, Bt[n][k]), __builtin_bit_cast(half8, At[m][k]), acc[ai][bj][m][n], 0, 0, 0); __builtin_amdgcn_s_setprio(0); } while (0)
#define PG8_WAIT_V(n) asm volatile("s_waitcnt vmcnt(" #n ")" ::: "memory")
#define PG8_WAIT_L(n) asm volatile("s_waitcnt lgkmcnt(" #n ")" ::: "memory")
#define PG8_BAR __builtin_amdgcn_s_barrier()
#define PG8_SCHED __builtin_amdgcn_sched_barrier(0)
    Unit cur, nxt; int ui = 0;
    if (!S.next(0, cur)) return;
    f32x4 acc[2][2][4][2];
#pragma unroll
    for (int a = 0; a < 2; ++a)
#pragma unroll
        for (int b = 0; b < 2; ++b)
#pragma unroll
            for (int m = 0; m < 4; ++m)
#pragma unroll
                for (int n = 0; n < 2; ++n) acc[a][b][m][n] = (f32x4){0.f, 0.f, 0.f, 0.f};
    bf16x8 At[4][2], B0[2][2], B1[2][2];
    const char* cA = (const char*)g.A + (size_t)cur.pm * tstep; const char* cB = (const char*)g.Bt + (size_t)cur.pn * tstep;
    S.a_ready(cur);
    if constexpr (SP2) {
        PG8_STAGE(PG8_SB(0, 0), cB, voffB); PG8_STAGE(PG8_SB(0, 1), cB + hstep, voffB); PG8_STAGE(PG8_SA(0, 0), cA, voffA); PG8_STAGE(PG8_SA(0, 1), cA + hstep, voffA);
        if (wr == 1) PG8_BAR;
        PG8_WAIT_V(2); PG8_BAR;
        PG8_STAGE(PG8_SB(1, 0), cB + kstep, voffB); PG8_STAGE(PG8_SA(1, 0), cA + kstep, voffA); PG8_STAGE(PG8_SB(1, 1), cB + hstep + kstep, voffB);
        PG8_WAIT_V(6); PG8_BAR;
    } else {
        PG8_STAGE(PG8_SB(0, 0), cB, voffB); PG8_STAGE(PG8_SA(0, 0), cA, voffA); PG8_STAGE(PG8_SB(0, 1), cB + hstep, voffB); PG8_STAGE(PG8_SA(0, 1), cA + hstep, voffA);
        if (wr == 1) PG8_BAR;
        PG8_WAIT_V(4); PG8_BAR;
        PG8_STAGE(PG8_SB(1, 0), cB + kstep, voffB); PG8_STAGE(PG8_SA(1, 0), cA + kstep, voffA); PG8_STAGE(PG8_SB(1, 1), cB + hstep + kstep, voffB);
        PG8_WAIT_V(6); PG8_BAR;
    }
    for (;;) {
        const bool has_next = S.next(ui + 1, nxt);
        const char* nA = has_next ? (const char*)g.A + (size_t)nxt.pm * tstep : cA; const char* nB = has_next ? (const char*)g.Bt + (size_t)nxt.pn * tstep : cB;
        for (int t = 0; t < nt; t += 2) {
            const bool last = (t == nt - 2);
            const char* a1 = cA + (size_t)(t + 1) * kstep;
            const char* a2 = last ? nA : cA + (size_t)(t + 2) * kstep; const char* b2 = last ? nB : cB + (size_t)(t + 2) * kstep;
            const char* a3 = a2 + kstep; const char* b3 = b2 + kstep;
            if (last && has_next) S.a_ready(nxt);
            if constexpr (SP2) {
            PG8_LDB(B0, 0, 0); PG8_LDB(B1, 0, 1); PG8_SCHED; PG8_LDA(At, 0, 0); PG8_STAGE(PG8_SA(1, 1), a1 + hstep, voffA);
            PG8_WAIT_V(8); PG8_WAIT_L(0); PG8_BAR; PG8_MMA(0, 0, At, B0); PG8_MMA(0, 1, At, B1); PG8_BAR; PG8_SCHED;
            PG8_LDA(At, 0, 1); PG8_STAGE(PG8_SB(0, 0), b2, voffB); PG8_STAGE(PG8_SB(0, 1), b2 + hstep, voffB); PG8_STAGE(PG8_SA(0, 0), a2, voffA);
            PG8_WAIT_V(8); PG8_WAIT_L(0); PG8_BAR; PG8_MMA(1, 0, At, B0); PG8_MMA(1, 1, At, B1); PG8_BAR; PG8_SCHED;
            PG8_LDB(B0, 1, 0); PG8_LDB(B1, 1, 1); PG8_SCHED; PG8_LDA(At, 1, 0); PG8_STAGE(PG8_SA(0, 1), a2 + hstep, voffA);
            PG8_WAIT_V(8); PG8_WAIT_L(0); PG8_BAR; PG8_MMA(0, 0, At, B0); PG8_MMA(0, 1, At, B1); PG8_BAR; PG8_SCHED;
            PG8_LDA(At, 1, 1); PG8_STAGE(PG8_SB(1, 0), b3, voffB); PG8_STAGE(PG8_SB(1, 1), b3 + hstep, voffB); PG8_STAGE(PG8_SA(1, 0), a3, voffA);
            PG8_WAIT_V(8); PG8_WAIT_L(0); PG8_BAR; PG8_MMA(1, 0, At, B0); PG8_MMA(1, 1, At, B1); PG8_BAR; PG8_SCHED;
            } else {
            PG8_LDB(B0, 0, 0); PG8_SCHED; PG8_LDA(At, 0, 0); PG8_STAGE(PG8_SA(1, 1), a1 + hstep, voffA);
            PG8_WAIT_L(8); PG8_BAR; PG8_WAIT_L(0); PG8_MMA(0, 0, At, B0); PG8_BAR; PG8_SCHED;
            PG8_LDB(B1, 0, 1); PG8_STAGE(PG8_SB(0, 0), b2, voffB);
            PG8_BAR; PG8_WAIT_L(0); PG8_MMA(0, 1, At, B1); PG8_BAR;
            PG8_LDA(At, 0, 1); PG8_STAGE(PG8_SA(0, 0), a2, voffA);
            PG8_BAR; PG8_WAIT_L(0); PG8_MMA(1, 0, At, B0); PG8_BAR; PG8_SCHED;
            PG8_STAGE(PG8_SB(0, 1), b2 + hstep, voffB);
            PG8_WAIT_V(6); PG8_BAR; PG8_MMA(1, 1, At, B1); PG8_BAR;
            PG8_LDB(B0, 1, 0); PG8_SCHED; PG8_LDA(At, 1, 0); PG8_STAGE(PG8_SA(0, 1), a2 + hstep, voffA);
            PG8_WAIT_L(8); PG8_BAR; PG8_WAIT_L(0); PG8_MMA(0, 0, At, B0); PG8_BAR; PG8_SCHED;
            PG8_LDB(B1, 1, 1); PG8_STAGE(PG8_SB(1, 0), b3, voffB);
            PG8_BAR; PG8_WAIT_L(0); PG8_MMA(0, 1, At, B1); PG8_BAR;
            PG8_LDA(At, 1, 1); PG8_STAGE(PG8_SA(1, 0), a3, voffA);
            PG8_BAR; PG8_WAIT_L(0); PG8_MMA(1, 0, At, B0); PG8_BAR; PG8_SCHED;
            PG8_STAGE(PG8_SB(1, 1), b3 + hstep, voffB);
            PG8_WAIT_V(6); PG8_BAR; PG8_MMA(1, 1, At, B1); PG8_BAR;
            }
        }
        if constexpr (ALIGN_EPI) { if (wr == 0) PG8_BAR; }
        if constexpr (!Epi::AFTER_DRAIN) { E(acc, cur, wr, wc, fr, fq); S.done(cur); }
        if (!has_next) break;
#pragma unroll
        for (int a = 0; a < 2; ++a)
#pragma unroll
            for (int b = 0; b < 2; ++b)
#pragma unroll
                for (int m = 0; m < 4; ++m)
#pragma unroll
                    for (int n = 0; n < 2; ++n) acc[a][b][m][n] = (f32x4){0.f, 0.f, 0.f, 0.f};
        cur = nxt; cA = nA; cB = nB; ++ui;
        if constexpr (ALIGN_EPI) { if (wr == 1) PG8_BAR; }
    }
    PG8_WAIT_V(0);
    if constexpr (!ALIGN_EPI) { if (wr == 0) PG8_BAR; }
    PG8_BAR;
    if constexpr (Epi::AFTER_DRAIN) { E.fused(acc, cur, wr, wc, fr, fq, lds, wid, lane); S.done(cur); }
#undef PG8_SA
#undef PG8_SB
#undef PG8_STAGE
#undef PG8_LDA
#undef PG8_LDB
#undef PG8_MMA
#undef PG8_WAIT_V
#undef PG8_WAIT_L
#undef PG8_BAR
#undef PG8_SCHED
}
}
#define GAS __attribute__((address_space(1)))
#define LAS __attribute__((address_space(3)))
typedef unsigned short bf16;
typedef unsigned v4u __attribute__((ext_vector_type(4)));
typedef float f32x4 __attribute__((ext_vector_type(4)));
typedef short bf16x8 __attribute__((ext_vector_type(8)));
typedef GAS unsigned gu32;
typedef GAS unsigned long long gu64;
#define RLX_AGENT __ATOMIC_RELAXED, __HIP_MEMORY_SCOPE_AGENT
#define LDS_WAIT() asm volatile("s_waitcnt lgkmcnt(0)" ::: "memory")
#define VM_WAIT() asm volatile("s_waitcnt vmcnt(0)" ::: "memory")
__device__ __forceinline__ unsigned long long rt() { return __builtin_amdgcn_s_memrealtime(); }
__device__ __forceinline__ unsigned f2bf(float f) { unsigned u = __builtin_bit_cast(unsigned, f); return (u + 0x7fffu + ((u >> 16) & 1u)) >> 16; }
__device__ __forceinline__ unsigned pk2(float lo, float hi) { return f2bf(lo) | (f2bf(hi) << 16); }

#define XB_TMO      128
#define XB_XCNT(j)  (256  + 64 * (j))
#define XB_XSUB(j)  (1280 + 64 * (j))
#define XB_XGEN(j)  (2304 + 64 * (j))
#define XB_TOP      3328
#define XB_TOPGEN   3392
#define XCD_BAR_WORDS 3456
#define XB_SPIN_CAP (1u << 18)

__device__ __forceinline__ unsigned xb_ld(unsigned* p)              { return __hip_atomic_load(p, __ATOMIC_RELAXED, __HIP_MEMORY_SCOPE_AGENT); }
__device__ __forceinline__ unsigned xb_add(unsigned* p, unsigned v) { return __hip_atomic_fetch_add(p, v, __ATOMIC_RELAXED, __HIP_MEMORY_SCOPE_AGENT); }
__device__ __forceinline__ unsigned xb_xcc_id() { return (unsigned)__builtin_amdgcn_s_getreg((3 << 11) | 20) & 0xFu; }
#define XB_SPIN(cond, bar) do { unsigned _sp = 0; while (cond) { __builtin_amdgcn_s_sleep(1); \
    if ((++_sp & 255u) == 0u) { if (xb_ld(&(bar)[XB_TMO])) break; if (_sp > XB_SPIN_CAP) { atomicAdd(&(bar)[XB_TMO], 1u); break; } } } } while (0)

struct XcdBarrier {
    unsigned* bar; unsigned x;
    volatile LAS unsigned* st;
};

__device__ __forceinline__ XcdBarrier xcd_barrier_post(unsigned* bar, volatile LAS unsigned* st) {
    XcdBarrier b; b.bar = bar; b.x = xb_xcc_id(); b.st = st;
    if (threadIdx.x == 0) (void)xb_add(&bar[XB_XCNT(b.x)], 1u);
    return b;
}
__device__ __forceinline__ void xcd_barrier_complete(unsigned* bar, unsigned x, unsigned& nloc, unsigned& nx) {
    const unsigned G = gridDim.x * gridDim.y * gridDim.z;
    unsigned sum, cnt, mine, sp = 0u;
    for (;;) {
        sum = 0u; cnt = 0u; mine = 0u;
#pragma unroll
        for (unsigned j = 0; j < 16; ++j) { const unsigned c = xb_ld(&bar[XB_XCNT(j)]); sum += c; cnt += (c > 0u) ? 1u : 0u; mine = (j == x) ? c : mine; }
        if (sum == G) break;
        __builtin_amdgcn_s_sleep(1);
        if ((++sp & 255u) == 0u) { if (xb_ld(&bar[XB_TMO])) break; if (sp > XB_SPIN_CAP) { atomicAdd(&bar[XB_TMO], 1u); break; } }
    }
    nloc = mine > 0u ? mine : 1u; nx = cnt > 0u ? cnt : 1u;
}

__device__ __forceinline__ void xcd_barrier(const XcdBarrier& b) {
    asm volatile("s_waitcnt vmcnt(0)" ::: "memory");
    __syncthreads();
    if (threadIdx.x == 0) {
        unsigned* bar = b.bar;
        __builtin_amdgcn_s_waitcnt(0);
        unsigned nloc = b.st[0], nx = b.st[1];
        if (nloc == 0u) { xcd_barrier_complete(bar, b.x, nloc, nx); b.st[0] = nloc; b.st[1] = nx; }
        const unsigned old = xb_add(&bar[XB_XSUB(b.x)], 1u);
        const unsigned gen = old / nloc;
        if (old + 1u == (gen + 1u) * nloc) {
            __builtin_amdgcn_fence(__ATOMIC_RELEASE, "agent");
            asm volatile("s_waitcnt vmcnt(0)" ::: "memory");
            const unsigned og = xb_add(&bar[XB_TOP], 1u);
            const unsigned tg = og / nx;
            if (og + 1u == (tg + 1u) * nx) xb_add(&bar[XB_TOPGEN], 1u);
            else XB_SPIN(xb_ld(&bar[XB_TOPGEN]) == tg, bar);
            __builtin_amdgcn_fence(__ATOMIC_ACQUIRE, "agent");
            xb_add(&bar[XB_XGEN(b.x)], 1u);
            asm volatile("s_waitcnt vmcnt(0)" ::: "memory");
        } else {
            XB_SPIN(xb_ld(&bar[XB_XGEN(b.x)]) == gen, bar);
            __builtin_amdgcn_fence(__ATOMIC_ACQUIRE, "agent");
            asm volatile("s_waitcnt vmcnt(0)" ::: "memory");
        }
    }
    __syncthreads();
}

constexpr int BATCH = 2, SEQ = 8192, DM = 1024, MTOK = BATCH * SEQ;
constexpr int DLAT = 256, TOPK = 256, DFF = 2816, DIN = 5456, NWIN = 5632;
constexpr int NWAVES = 8, NTHR = 512;
constexpr float EPS = 1e-6f;
constexpr float IDX_SCALE = 0.04419417382415922f;
constexpr int NKS = 16;

constexpr size_t MiB = 1u << 20;
constexpr size_t WS_CTL = 0, CTL_ZERO_BYTES = 1 * MiB;
constexpr size_t WS_W13A = 1 * MiB;
constexpr size_t WS_W2A  = 12 * MiB;
constexpr size_t WS_WIN  = 18 * MiB;
constexpr size_t WS_WBA  = 29 * MiB;
constexpr size_t WS_WBM  = 30 * MiB;
constexpr size_t WS_WOUT = 31 * MiB;
constexpr size_t WS_WUK  = 33 * MiB;
constexpr size_t WS_WUVT = 33 * MiB + 256 * 1024;
constexpr size_t WS_MODP = 33 * MiB + 512 * 1024;
constexpr size_t WS_MOD  = 34 * MiB + 768 * 1024;
constexpr size_t WS_XN   = 35 * MiB;
constexpr size_t WS_HID  = 67 * MiB;
constexpr size_t WS_QA   = 67 * MiB;
constexpr size_t WS_CKV  = 83 * MiB;
constexpr size_t WS_QIDX = 91 * MiB;
constexpr size_t WS_KIDX = 107 * MiB;
constexpr size_t WS_WIDX = 109 * MiB;
constexpr size_t WS_GI   = 109 * MiB + 512 * 1024;
constexpr size_t WS_GF   = 109 * MiB + 768 * 1024;
constexpr size_t WS_QM   = 110 * MiB;
constexpr size_t WS_KM   = 126 * MiB;
constexpr size_t WS_VM   = 142 * MiB;
constexpr size_t WS_OG   = 158 * MiB;
constexpr size_t WS_GA   = 174 * MiB;
constexpr size_t WS_GM   = 206 * MiB;
constexpr size_t WS_Q2   = 238 * MiB;
constexpr size_t WS_SEL  = 1 * MiB;
constexpr size_t WS_K2   = 9 * MiB;
constexpr size_t WS_NVEC = 25 * MiB;
constexpr size_t WS_MLOC = 25 * MiB + 512 * 1024;
constexpr size_t WS_BLAST= 25 * MiB + 520 * 1024;
constexpr size_t WS_NST  = 26 * MiB;
constexpr size_t WS_MST  = 26 * MiB + 512 * 1024;
constexpr size_t WS_UT   = 35 * MiB;
constexpr size_t WS_YA   = 91 * MiB;
constexpr size_t WS_CT   = 110 * MiB;
constexpr size_t WS_HM   = 35 * MiB;
constexpr size_t WS_MRG  = 110 * MiB;
constexpr size_t WS_W13B = 1 * MiB;
constexpr size_t WS_W2B  = 12 * MiB;
constexpr size_t WS_END  = 256 * MiB;

constexpr int CW_BAR = 4096;

constexpr int LDS_BYTES = 160 * 1024;
constexpr int MISC_OFF = LDS_BYTES - 256;

#define WAVE_SUM(v) do { _Pragma("unroll") for (int _o = 1; _o < 64; _o <<= 1) v += __shfl_xor(v, _o); } while (0)
#define WAVE_MAX(v) do { _Pragma("unroll") for (int _o = 1; _o < 64; _o <<= 1) v = fmaxf(v, __shfl_xor(v, _o)); } while (0)

typedef unsigned u32x4 __attribute__((ext_vector_type(4)));
typedef unsigned u32x2 __attribute__((ext_vector_type(2)));

__device__ __forceinline__ float silu_f(float a) { return a * __builtin_amdgcn_rcpf(1.f + __expf(-a)); }
__device__ __forceinline__ float sigmoid_f(float a) { return __builtin_amdgcn_rcpf(1.f + __expf(-a)); }
__device__ __forceinline__ float logsigmoid_f(float x) { return fminf(x, 0.f) - log1pf(__expf(-fabsf(x))); }
__device__ __forceinline__ half8 pack8(const float* v) { half8 r; _Pragma("unroll") for (int i = 0; i < 8; ++i) r[i] = (h16)v[i]; return r; }
__device__ __forceinline__ f32x4 mfma16(half8 a, half8 b, f32x4 c) { return __builtin_amdgcn_mfma_f32_16x16x32_f16(a, b, c, 0, 0, 0); }

struct Args { const float* in[26]; float* out; unsigned char* ws; int ph_lo, ph_hi; };

struct EpiSwiGLU {
    static constexpr bool PERM = true, AFTER_DRAIN = false;
    h16* O;
    __device__ __forceinline__ void operator()(const pg8::f32x4 (&acc)[2][2][4][2], const pg8::Unit& u, int wr, int wc, int fr, int fq) const {
        const int row0 = u.pm * 256 + wr * 64 + fr, col0 = u.pn * 128 + wc * 32 + 8 * fq;
#pragma unroll
        for (int ai = 0; ai < 2; ++ai)
#pragma unroll
            for (int m = 0; m < 4; ++m) {
                h16* rowp = O + (size_t)(row0 + ai * 128 + m * 16) * DFF + col0;
                float r[8];
#pragma unroll
                for (int n = 0; n < 2; ++n)
#pragma unroll
                    for (int i = 0; i < 4; ++i) r[n * 4 + i] = silu_f(acc[ai][0][m][n][i]) * acc[ai][1][m][n][i];
                *(half8*)rowp = pack8(r);
            }
    }
};
struct EpiResid {
    static constexpr bool PERM = false, AFTER_DRAIN = false;
    const float* res; float* out; const float* gmod; float gs;
    __device__ __forceinline__ void operator()(const pg8::f32x4 (&acc)[2][2][4][2], const pg8::Unit& u, int wr, int wc, int fr, int fq) const {
        const int row0 = u.pm * 256 + wr * 64 + fr, col0 = u.pn * 256 + wc * 32 + 4 * fq;
        const float* gp = gmod + (size_t)(u.pm >> 5) * 9216 + col0;
        pg8::f32x4 g[2][2];
#pragma unroll
        for (int bj = 0; bj < 2; ++bj)
#pragma unroll
            for (int n = 0; n < 2; ++n) g[bj][n] = *(const pg8::f32x4*)(gp + bj * 128 + n * 16) * gs;
#pragma unroll
        for (int ai = 0; ai < 2; ++ai)
#pragma unroll
            for (int m = 0; m < 4; ++m) {
                const size_t off = (size_t)(row0 + ai * 128 + m * 16) * DM + col0;
#pragma unroll
                for (int bj = 0; bj < 2; ++bj)
#pragma unroll
                    for (int n = 0; n < 2; ++n) {
                        const pg8::f32x4 rv = *(const pg8::f32x4*)(res + off + bj * 128 + n * 16);
                        *(pg8::f32x4*)(out + off + bj * 128 + n * 16) = rv + g[bj][n] * acc[ai][bj][m][n];
                    }
            }
    }
};
struct EpiWin {
    static constexpr bool PERM = true, AFTER_DRAIN = false;
    unsigned char* ws; const float* gate_bias;
    __device__ __forceinline__ void operator()(const pg8::f32x4 (&acc)[2][2][4][2], const pg8::Unit& u, int wr, int wc, int fr, int fq) const {
        const int pn = u.pn;
        const int row0 = u.pm * 256 + wr * 64 + fr, cc0 = wc * 32 + 8 * fq;
        if (pn == 5) {
            h16* KIDX = (h16*)(ws + WS_KIDX); float* WIDX = (float*)(ws + WS_WIDX); float* GI = (float*)(ws + WS_GI); float* GF = (float*)(ws + WS_GF);
#pragma unroll
            for (int ai = 0; ai < 2; ++ai)
#pragma unroll
                for (int m = 0; m < 4; ++m) {
                    const int row = row0 + ai * 128 + m * 16;
                    if (cc0 < 64) {
                        float r[8];
#pragma unroll
                        for (int n = 0; n < 2; ++n)
#pragma unroll
                            for (int i = 0; i < 4; ++i) r[n * 4 + i] = acc[ai][0][m][n][i];
                        *(half8*)(KIDX + (size_t)row * 64 + cc0) = pack8(r);
                    } else if (cc0 == 64) {
#pragma unroll
                        for (int n = 0; n < 2; ++n) *(pg8::f32x4*)(WIDX + (size_t)row * 8 + n * 4) = acc[ai][0][m][n] * IDX_SCALE;
                    } else if (cc0 == 72) {
                        pg8::f32x4 gi, gf;
#pragma unroll
                        for (int i = 0; i < 4; ++i) { gi[i] = acc[ai][0][m][0][i] + gate_bias[i]; gf[i] = logsigmoid_f(acc[ai][0][m][1][i] + gate_bias[4 + i]); }
                        *(pg8::f32x4*)(GI + (size_t)row * 4) = gi; *(pg8::f32x4*)(GF + (size_t)row * 4) = gf;
                    }
                }
            return;
        }
        size_t dst; int ld, cb; bool sg = false;
        if (pn < 2)       { dst = WS_QA;   ld = 512;  cb = pn * 256; }
        else if (pn == 2) { dst = WS_CKV;  ld = 256;  cb = 0; }
        else if (pn < 5)  { dst = WS_QIDX; ld = 512;  cb = (pn - 3) * 256; }
        else if (pn < 8)  { dst = WS_QM;   ld = 512;  cb = (pn - 6) * 256; }
        else if (pn < 10) { dst = WS_KM;   ld = 512;  cb = (pn - 8) * 256; }
        else if (pn < 12) { dst = WS_VM;   ld = 512;  cb = (pn - 10) * 256; }
        else if (pn < 14) { dst = WS_OG;   ld = 512;  cb = (pn - 12) * 256; sg = true; }
        else if (pn < 18) { dst = WS_GA;   ld = 1024; cb = (pn - 14) * 256; sg = true; }
        else              { dst = WS_GM;   ld = 1024; cb = (pn - 18) * 256; sg = true; }
        h16* O = (h16*)(ws + dst);
#pragma unroll
        for (int ai = 0; ai < 2; ++ai)
#pragma unroll
            for (int m = 0; m < 4; ++m) {
                h16* rowp = O + (size_t)(row0 + ai * 128 + m * 16) * ld + cb + cc0;
#pragma unroll
                for (int bj = 0; bj < 2; ++bj) {
                    float r[8];
#pragma unroll
                    for (int n = 0; n < 2; ++n)
#pragma unroll
                        for (int i = 0; i < 4; ++i) { const float v = acc[ai][bj][m][n][i]; r[n * 4 + i] = sg ? sigmoid_f(v) : v; }
                    *(half8*)(rowp + bj * 128) = pack8(r);
                }
            }
    }
};
template <bool ACCUM> struct EpiMerge {
    static constexpr bool PERM = true, AFTER_DRAIN = false;
    const h16* gate; h16* O;
    __device__ __forceinline__ void operator()(const pg8::f32x4 (&acc)[2][2][4][2], const pg8::Unit& u, int wr, int wc, int fr, int fq) const {
        const int row0 = u.pm * 256 + wr * 64 + fr, col0 = u.pn * 256 + wc * 32 + 8 * fq;
#pragma unroll
        for (int ai = 0; ai < 2; ++ai)
#pragma unroll
            for (int m = 0; m < 4; ++m) {
                const size_t off = (size_t)(row0 + ai * 128 + m * 16) * DM + col0;
#pragma unroll
                for (int bj = 0; bj < 2; ++bj) {
                    const half8 gv = *(const half8*)(gate + off + bj * 128);
                    half8 ov; if (ACCUM) ov = *(const half8*)(O + off + bj * 128);
                    float r[8];
#pragma unroll
                    for (int n = 0; n < 2; ++n)
#pragma unroll
                        for (int i = 0; i < 4; ++i) { float v = (float)gv[n * 4 + i] * acc[ai][bj][m][n][i]; if (ACCUM) v += (float)ov[n * 4 + i]; r[n * 4 + i] = v; }
                    *(half8*)(O + off + bj * 128) = pack8(r);
                }
            }
    }
};

template <int MAP> __device__ __forceinline__ int wmap(int j) {
    if (MAP == 0) return j;
    if (MAP == 1) return 256 * (j >> 7) + (j & 127);
    if (MAP == 2) return 256 * (j >> 7) + 128 + (j & 127);
    if (j < 1352) return j;
    if (j < 1864) return 1536 + (j - 1352);
    if (j < 2376) return 2048 + (j - 1864);
    if (j < 2888) return 2560 + (j - 2376);
    if (j < 2892) return 1352 + (j - 2888);
    if (j < 2896) return 1356 + (j - 2892);
    if (j < 3408) return 3072 + (j - 2896);
    if (j < 4432) return 3584 + (j - 3408);
    return 4608 + (j - 4432);
}
template <int MAP> __device__ __forceinline__ void transpose_item(const float* W, int K, int N, h16* WT, LAS float* scr, int item, int lane) {
    const int nblk = (N + 31) / 32, kb = item / nblk, nb = item % nblk, k0 = 64 * kb, n0 = 32 * nb;
    const int ncol = n0 + (lane & 31);
#pragma unroll 8
    for (int i = 0; i < 32; ++i) { const int kk = 2 * i + (lane >> 5); scr[kk * 33 + (lane & 31)] = (ncol < N) ? W[(size_t)(k0 + kk) * N + ncol] : 0.f; }
    asm volatile("s_waitcnt lgkmcnt(0)" ::: "memory");
    const int c = lane & 7;
#pragma unroll
    for (int j = 0; j < 4; ++j) {
        const int n = (lane >> 3) + 8 * j; const LAS float* s = scr + (8 * c) * 33 + n;
        float v[8];
#pragma unroll
        for (int q = 0; q < 8; ++q) v[q] = s[q * 33];
        if (n0 + n < N) *(half8*)(WT + (size_t)wmap<MAP>(n0 + n) * K + k0 + 8 * c) = pack8(v);
    }
    asm volatile("s_waitcnt lgkmcnt(0)" ::: "memory");
}
template <int MAP> __device__ __forceinline__ void transpose_mat(const float* W, int K, int N, h16* WT, LAS float* scr, int gw, int ngw, int lane) {
    const int nitems = (K / 64) * ((N + 31) / 32);
    for (int it = gw; it < nitems; it += ngw) transpose_item<MAP>(W, K, N, WT, scr, it, lane);
}

__device__ __forceinline__ void phase_prologue(const Args& a, LAS unsigned char* lds, int vcu, int G) {
    const int tid = threadIdx.x, lane = tid & 63, wave = __builtin_amdgcn_readfirstlane(tid >> 6);
    unsigned char* ws = a.ws;
    LAS float* scr = (LAS float*)(lds + wave * 16384);
    const int gw = vcu * NWAVES + wave, ngw = G * NWAVES;
    transpose_mat<1>(a.in[5], DM, DFF, (h16*)(ws + WS_W13A), scr, gw, ngw, lane);
    transpose_mat<2>(a.in[6], DM, DFF, (h16*)(ws + WS_W13A), scr, gw, ngw, lane);
    transpose_mat<0>(a.in[7], DFF, DM, (h16*)(ws + WS_W2A), scr, gw, ngw, lane);
    transpose_mat<3>(a.in[9], DM, DIN, (h16*)(ws + WS_WIN), scr, gw, ngw, lane);
    transpose_mat<0>(a.in[18], 512, DM, (h16*)(ws + WS_WBA), scr, gw, ngw, lane);
    transpose_mat<0>(a.in[19], 512, DM, (h16*)(ws + WS_WBM), scr, gw, ngw, lane);
    transpose_mat<0>(a.in[20], DM, DM, (h16*)(ws + WS_WOUT), scr, gw, ngw, lane);
    {
        const float* wuk = a.in[13]; const float* wuv = a.in[14]; h16* ouk = (h16*)(ws + WS_WUK); h16* ouvt = (h16*)(ws + WS_WUVT);
        for (int i = vcu * NTHR + tid; i < 8 * 256 * 64; i += G * NTHR) {
            ouk[i] = (h16)wuk[i];
            const int h = i >> 14, d = (i >> 8) & 63, c = i & 255;
            ouvt[i] = (h16)wuv[(h * 256 + c) * 64 + d];
        }
    }
    {
        const float* cin = a.in[1]; const float* aw = a.in[2]; float* modp = (float*)(ws + WS_MODP);
        for (int it = vcu; it < NKS * 18; it += G) {
            const int ks = it / 18, cb = it % 18, j = cb * 512 + tid;
            float a0 = 0.f, a1 = 0.f;
#pragma unroll 8
            for (int k = ks * 64; k < ks * 64 + 64; ++k) {
                const float w = aw[(size_t)k * 9216 + j];
                a0 += silu_f(cin[k]) * w; a1 += silu_f(cin[DM + k]) * w;
            }
            modp[(size_t)(ks * 2 + 0) * 9216 + j] = a0; modp[(size_t)(ks * 2 + 1) * 9216 + j] = a1;
        }
    }
}

__device__ __forceinline__ void convert_ffn2_weights(const Args& a, LAS unsigned char* lds, int vcu, int G) {
    const int tid = threadIdx.x, lane = tid & 63, wave = __builtin_amdgcn_readfirstlane(tid >> 6);
    LAS float* scr = (LAS float*)(lds + 32768 + wave * 16384);
    const int gw = vcu * NWAVES + wave, ngw = G * NWAVES;
    transpose_mat<1>(a.in[22], DM, DFF, (h16*)(a.ws + WS_W13B), scr, gw, ngw, lane);
    transpose_mat<2>(a.in[23], DM, DFF, (h16*)(a.ws + WS_W13B), scr, gw, ngw, lane);
    transpose_mat<0>(a.in[24], DFF, DM, (h16*)(a.ws + WS_W2B), scr, gw, ngw, lane);
}

template <int MODE> __device__ __forceinline__ void phase_norm(const Args& a, LAS unsigned char* lds, int vcu, int G, const float* xin, const float* gain, int chunk_sh, h16* xn_out, float* f32_out) {
    const int tid = threadIdx.x, lane = tid & 63, wave = __builtin_amdgcn_readfirstlane(tid >> 6);
    LAS float* modL = (LAS float*)lds;
    const float* modp = (const float*)(a.ws + WS_MODP); float* mod = (float*)(a.ws + WS_MOD); const float* adab = a.in[3];
    if (MODE == 0) {
        for (int i = tid; i < 4096; i += NTHR) {
            const int b = i >> 11, which = (i >> 10) & 1, col = i & 1023, j = (chunk_sh + which) * 1024 + col;
            float s = adab[j];
            for (int ks = 0; ks < NKS; ++ks) s += modp[(size_t)(ks * 2 + b) * 9216 + j];
            modL[i] = which ? 1.f + s : s;
        }
        for (int i = vcu * NTHR + tid; i < 2 * 9216; i += G * NTHR) {
            const int b = i / 9216, j = i % 9216;
            float s = adab[j];
            for (int ks = 0; ks < NKS; ++ks) s += modp[(size_t)(ks * 2 + b) * 9216 + j];
            mod[i] = s;
        }
        __syncthreads();
    } else if (MODE == 1) {
        for (int i = tid; i < 4096; i += NTHR) {
            const int b = i >> 11, which = (i >> 10) & 1, col = i & 1023;
            const float s = mod[(size_t)b * 9216 + (chunk_sh + which) * 1024 + col];
            modL[i] = which ? 1.f + s : s;
        }
        __syncthreads();
    }
    const int gw = vcu * NWAVES + wave, ngw = G * NWAVES;
    for (int m = gw; m < MTOK; m += ngw) {
        const pg8::f32x4* xr = (const pg8::f32x4*)(xin + (size_t)m * DM) + lane;
        pg8::f32x4 v[4]; float s = 0.f;
#pragma unroll
        for (int j = 0; j < 4; ++j) { v[j] = xr[64 * j]; s += (v[j].x * v[j].x + v[j].y * v[j].y) + (v[j].z * v[j].z + v[j].w * v[j].w); }
        WAVE_SUM(s);
        const float rstd = 1.0f / sqrtf(s * (1.f / DM) + EPS);
        const int b = m / SEQ;
#pragma unroll
        for (int j = 0; j < 4; ++j) {
            const int col = 4 * lane + 256 * j;
            const pg8::f32x4 g = *(const pg8::f32x4*)(gain + col);
            pg8::f32x4 y = v[j] * rstd * g;
            if (MODE == 2) { *((pg8::f32x4*)(f32_out + (size_t)m * DM) + lane + 64 * j) = y; }
            else {
                const pg8::f32x4 sh = *(const LAS pg8::f32x4*)(modL + (b * 2 + 0) * 1024 + col), sc = *(const LAS pg8::f32x4*)(modL + (b * 2 + 1) * 1024 + col);
                y = y * sc + sh;
                half4 o; o[0] = (h16)y.x; o[1] = (h16)y.y; o[2] = (h16)y.z; o[3] = (h16)y.w;
                *(half4*)(xn_out + (size_t)m * DM + col) = o;
            }
        }
    }
}

__device__ __forceinline__ void kv_finalize(const Args& a, int vcu, int G) {
    const int tid = threadIdx.x, lane = tid & 63, wave = __builtin_amdgcn_readfirstlane(tid >> 6);
    h16* ckv = (h16*)(a.ws + WS_CKV); const float* g = a.in[12];
    const int gw = vcu * NWAVES + wave, ngw = G * NWAVES;
    const pg8::f32x4 gv = *(const pg8::f32x4*)(g + 4 * lane);
    for (int m = gw; m < MTOK; m += ngw) {
        half4 v = *(half4*)(ckv + (size_t)m * 256 + 4 * lane);
        float f0 = (float)v[0], f1 = (float)v[1], f2 = (float)v[2], f3 = (float)v[3];
        float s = (f0 * f0 + f1 * f1) + (f2 * f2 + f3 * f3);
        WAVE_SUM(s);
        const float rstd = 1.0f / sqrtf(s * (1.f / 256.f) + EPS);
        half4 o; o[0] = (h16)(f0 * rstd * gv.x); o[1] = (h16)(f1 * rstd * gv.y); o[2] = (h16)(f2 * rstd * gv.z); o[3] = (h16)(f3 * rstd * gv.w);
        *(half4*)(ckv + (size_t)m * 256 + 4 * lane) = o;
    }
}

__device__ __forceinline__ unsigned f2key(float f) { const unsigned u = __float_as_uint(f); return (u & 0x80000000u) ? ~u : (u | 0x80000000u); }
__device__ __forceinline__ float key2f(unsigned k) { const unsigned u = (k & 0x80000000u) ? (k & 0x7fffffffu) : ~k; return __uint_as_float(u); }
constexpr int CAP = 512;
__device__ __forceinline__ unsigned select256(LAS float* scB, LAS unsigned short* ixB, int n, int lane) {
    unsigned key[8]; unsigned short idv[8]; float scv[8];
#pragma unroll
    for (int j = 0; j < 8; ++j) { const int i = lane + 64 * j; const bool ok = i < n; scv[j] = ok ? scB[i] : 0.f; idv[j] = ok ? ixB[i] : (unsigned short)0; key[j] = ok ? f2key(scv[j]) : 0u; }
    unsigned T = 0u;
    for (int bit = 31; bit >= 0; --bit) {
        const unsigned cand = T | (1u << bit); int c = 0;
#pragma unroll
        for (int j = 0; j < 8; ++j) c += __popcll(__ballot(key[j] >= cand));
        if (c >= TOPK) T = cand;
    }
    int ngt = 0;
#pragma unroll
    for (int j = 0; j < 8; ++j) ngt += __popcll(__ballot(key[j] > T));
    const int need_eq = TOPK - ngt;
    const unsigned long long lt = (1ull << lane) - 1ull;
    int base = 0, eqbase = 0;
#pragma unroll
    for (int j = 0; j < 8; ++j) {
        const bool gt = key[j] > T, eq = key[j] == T;
        const unsigned long long meq = __ballot(eq);
        const int eqrank = eqbase + __popcll(meq & lt);
        const bool keep = gt || (eq && eqrank < need_eq);
        const unsigned long long mk = __ballot(keep);
        const int pos = base + __popcll(mk & lt);
        if (keep) { scB[pos] = scv[j]; ixB[pos] = idv[j]; }
        base += __popcll(mk); eqbase += __popcll(meq);
    }
    return T;
}

__device__ __forceinline__ void indexer_unit(const Args& a, LAS unsigned char* lds, int b, int blk) {
    const int tid = threadIdx.x, lane = tid & 63, wave = __builtin_amdgcn_readfirstlane(tid >> 6);
    const h16* QIDX = (const h16*)(a.ws + WS_QIDX); const h16* KIDX = (const h16*)(a.ws + WS_KIDX); const float* WIDX = (const float*)(a.ws + WS_WIDX);
    unsigned short* SEL = (unsigned short*)(a.ws + WS_SEL);
    const int t0 = blk * 32; const size_t rowb = (size_t)b * SEQ;
    LAS unsigned char* st = lds;
    LAS float* scW = (LAS float*)(lds + 18432 + wave * 12288);
    LAS unsigned short* ixW = (LAS unsigned short*)(lds + 18432 + wave * 12288 + 8192);
    const int fr = lane & 15, fq = lane >> 4, tw = t0 + 4 * wave, t = tw + fq;
    half8 qa[2][2];
#pragma unroll
    for (int g = 0; g < 2; ++g)
#pragma unroll
        for (int ks = 0; ks < 2; ++ks) qa[g][ks] = *(const half8*)(QIDX + (rowb + tw + (fr >> 2)) * 512 + ((fr & 3) + 4 * g) * 64 + ks * 32 + fq * 8);
    const pg8::f32x4 w0 = *(const pg8::f32x4*)(WIDX + (rowb + t) * 8), w1 = *(const pg8::f32x4*)(WIDX + (rowb + t) * 8 + 4);
    float thr = -INFINITY; int cnt = 0;
    const int nst = t0 / 64 + 1;
    const h16* ksrc = KIDX + (rowb + (tid >> 3)) * 64 + (tid & 7) * 8;
    u32x4 pre = *(const u32x4*)ksrc;
    for (int si = 0; si < nst; ++si) {
        LAS unsigned char* sb = st + (si & 1) * 9216;
        *(LAS u32x4*)(sb + (tid >> 3) * 144 + (tid & 7) * 16) = pre;
        __syncthreads();
        if (si + 1 < nst) pre = *(const u32x4*)(ksrc + (size_t)(si + 1) * 64 * 64);
        const int s0 = si * 64;
#pragma unroll
        for (int kb = 0; kb < 4; ++kb) {
            const int sblk = s0 + 16 * kb;
            if (sblk <= tw + 3) {
                const half8 k0 = *(const LAS half8*)(sb + (16 * kb + fr) * 144 + fq * 16), k1 = *(const LAS half8*)(sb + (16 * kb + fr) * 144 + 64 + fq * 16);
                pg8::f32x4 a0 = {0.f, 0.f, 0.f, 0.f}, a1 = {0.f, 0.f, 0.f, 0.f};
                a0 = mfma16(qa[0][0], k0, a0); a0 = mfma16(qa[0][1], k1, a0);
                a1 = mfma16(qa[1][0], k0, a1); a1 = mfma16(qa[1][1], k1, a1);
                float sc = 0.f;
                sc = fmaf(w0.x, fmaxf(a0[0], 0.f), sc); sc = fmaf(w0.y, fmaxf(a0[1], 0.f), sc); sc = fmaf(w0.z, fmaxf(a0[2], 0.f), sc); sc = fmaf(w0.w, fmaxf(a0[3], 0.f), sc);
                sc = fmaf(w1.x, fmaxf(a1[0], 0.f), sc); sc = fmaf(w1.y, fmaxf(a1[1], 0.f), sc); sc = fmaf(w1.z, fmaxf(a1[2], 0.f), sc); sc = fmaf(w1.w, fmaxf(a1[3], 0.f), sc);
                const int s = sblk + fr;
                const bool pass = (s <= t) && (sc > thr);
                const unsigned long long mask = __ballot(pass);
                const unsigned fld = (unsigned)(mask >> (16 * fq)) & 0xffffu;
                const int prefix = __popc(fld & ((1u << fr) - 1u));
                if (pass) { const int p = cnt + prefix; scW[fq * CAP + p] = sc; ixW[fq * CAP + p] = (unsigned short)s; }
                cnt += __popc(fld);
            }
        }
#pragma unroll
        for (int tk = 0; tk < 4; ++tk) {
            const int c = __builtin_amdgcn_readlane(cnt, 16 * tk);
            if (c > CAP - 64) {
                const unsigned T = select256(scW + tk * CAP, ixW + tk * CAP, c, lane);
                if (fq == tk) { thr = key2f(T); cnt = TOPK; }
            }
        }
    }
#pragma unroll
    for (int tk = 0; tk < 4; ++tk) {
        int c = __builtin_amdgcn_readlane(cnt, 16 * tk);
        if (c > TOPK) { (void)select256(scW + tk * CAP, ixW + tk * CAP, c, lane); c = TOPK; }
#pragma unroll
        for (int i = 0; i < 4; ++i) { const int k = lane + 64 * i; SEL[(rowb + tw + tk) * 256 + k] = (k < c) ? ixW[tk * CAP + k] : (unsigned short)0xFFFF; }
    }
    __syncthreads();
}
__device__ __forceinline__ void phase_indexer(const Args& a, LAS unsigned char* lds, int vcu, int G) {
    for (int p = vcu; p < 256; p += G) { indexer_unit(a, lds, 0, p); indexer_unit(a, lds, 1, 255 - p); }
}

constexpr int SA_QABS = 0, SA_PW = 67584, SA_SELW = SA_PW + 65536, SA_BIAS = SA_SELW + 8192, SA_BKT = SA_BIAS + 1024, SA_END = SA_BKT + 512;
static_assert(SA_END <= MISC_OFF, "sparse attention LDS");
__device__ __forceinline__ void sattn_unit(const Args& a, LAS unsigned char* lds, int unit) {
    const int tid = threadIdx.x, lane = tid & 63, wave = __builtin_amdgcn_readfirstlane(tid >> 6);
    const int fr = lane & 15, fq = lane >> 4;
    const h16* QA = (const h16*)(a.ws + WS_QA); const h16* CKV = (const h16*)(a.ws + WS_CKV); const h16* WUK = (const h16*)(a.ws + WS_WUK); const h16* WUVT = (const h16*)(a.ws + WS_WUVT);
    const unsigned short* SEL = (const unsigned short*)(a.ws + WS_SEL); h16* YA = (h16*)(a.ws + WS_YA);
    LAS h16* QABS = (LAS h16*)(lds + SA_QABS); LAS float* PW = (LAS float*)(lds + SA_PW) + wave * 2048; LAS int* SELW = (LAS int*)(lds + SA_SELW) + wave * 256;
    LAS float* BIAS = (LAS float*)(lds + SA_BIAS); LAS int* BKT = (LAS int*)(lds + SA_BKT);
    const int row0 = unit * 16, b = row0 / SEQ, tpos0 = row0 - b * SEQ;
    const size_t rowb = (size_t)b * SEQ;
    {
        const int h = wave;
        half8 af[2];
#pragma unroll
        for (int ks = 0; ks < 2; ++ks) af[ks] = *(const half8*)(QA + (size_t)(row0 + fr) * 512 + h * 64 + ks * 32 + fq * 8);
#pragma unroll 4
        for (int cb = 0; cb < 16; ++cb) {
            pg8::f32x4 acc = {0.f, 0.f, 0.f, 0.f};
#pragma unroll
            for (int ks = 0; ks < 2; ++ks) acc = mfma16(af[ks], *(const half8*)(WUK + (size_t)(h * 256 + cb * 16 + fr) * 64 + ks * 32 + fq * 8), acc);
#pragma unroll
            for (int r = 0; r < 4; ++r) QABS[((4 * fq + r) * 8 + h) * 264 + cb * 16 + fr] = (h16)(acc[r] * 0.125f);
        }
    }
    __syncthreads();
#pragma unroll 1
    for (int tt = 0; tt < 2; ++tt) {
        const int tl = 2 * wave + tt, t = tpos0 + tl, row = row0 + tl;
#pragma unroll
        for (int i = 0; i < 4; ++i) SELW[lane + 64 * i] = (int)SEL[(size_t)row * 256 + lane + 64 * i];
        const int nvalid = (t + 1 < TOPK) ? t + 1 : TOPK;
        float sreg[16][4];
#pragma unroll
        for (int kb = 0; kb < 16; ++kb) {
            const int kidx = SELW[kb * 16 + fr];
            const int krow = (kidx != 0xFFFF) ? kidx : 0;
            const h16* kp = CKV + (rowb + krow) * 256 + fq * 8;
            pg8::f32x4 acc = {0.f, 0.f, 0.f, 0.f};
#pragma unroll
            for (int cs = 0; cs < 8; ++cs) acc = mfma16(*(const half8*)(kp + cs * 32), *(const LAS half8*)(QABS + (tl * 8 + (fr & 7)) * 264 + cs * 32 + fq * 8), acc);
#pragma unroll
            for (int r = 0; r < 4; ++r) {
                const int ks_ = SELW[kb * 16 + 4 * fq + r];
                const bool v = ks_ != 0xFFFF;
                int dist = t - ks_; dist = dist < 0 ? 0 : (dist > 127 ? 127 : dist);
                sreg[kb][r] = v ? acc[r] + BIAS[BKT[dist] * 8 + (fr & 7)] : -INFINITY;
            }
        }
        float mx = -INFINITY;
#pragma unroll
        for (int kb = 0; kb < 16; ++kb)
#pragma unroll
            for (int r = 0; r < 4; ++r) mx = fmaxf(mx, sreg[kb][r]);
        mx = fmaxf(mx, __shfl_xor(mx, 16)); mx = fmaxf(mx, __shfl_xor(mx, 32));
        float sum = 0.f;
#pragma unroll
        for (int kb = 0; kb < 16; ++kb)
#pragma unroll
            for (int r = 0; r < 4; ++r) { const float p = __expf(sreg[kb][r] - mx); sreg[kb][r] = p; sum += p; }
        sum += __shfl_xor(sum, 16); sum += __shfl_xor(sum, 32);
        const float inv = 1.f / sum;
        if (fr < 8) {
#pragma unroll
            for (int kb = 0; kb < 16; ++kb)
#pragma unroll
                for (int r = 0; r < 4; ++r) PW[(kb * 16 + 4 * fq + r) * 8 + fr] = sreg[kb][r] * inv;
        }
        float o[8][4];
#pragma unroll
        for (int h = 0; h < 8; ++h)
#pragma unroll
            for (int i = 0; i < 4; ++i) o[h][i] = 0.f;
#pragma unroll 4
        for (int k = 0; k < nvalid; ++k) {
            const int kidx = SELW[k];
            const half4 v = *(const half4*)(CKV + (rowb + kidx) * 256 + 4 * lane);
            const pg8::f32x4 p0 = *(const LAS pg8::f32x4*)(PW + k * 8), p1 = *(const LAS pg8::f32x4*)(PW + k * 8 + 4);
            const float vf[4] = {(float)v[0], (float)v[1], (float)v[2], (float)v[3]};
#pragma unroll
            for (int i = 0; i < 4; ++i) {
                o[0][i] += p0.x * vf[i]; o[1][i] += p0.y * vf[i]; o[2][i] += p0.z * vf[i]; o[3][i] += p0.w * vf[i];
                o[4][i] += p1.x * vf[i]; o[5][i] += p1.y * vf[i]; o[6][i] += p1.z * vf[i]; o[7][i] += p1.w * vf[i];
            }
        }
#pragma unroll
        for (int h = 0; h < 8; ++h) { half4 ov; ov[0] = (h16)o[h][0]; ov[1] = (h16)o[h][1]; ov[2] = (h16)o[h][2]; ov[3] = (h16)o[h][3]; *(LAS half4*)(QABS + (tl * 8 + h) * 264 + 4 * lane) = ov; }
    }
    __syncthreads();
    {
        const int h = wave;
#pragma unroll
        for (int db = 0; db < 4; ++db) {
            pg8::f32x4 acc = {0.f, 0.f, 0.f, 0.f};
#pragma unroll
            for (int cs = 0; cs < 8; ++cs) acc = mfma16(*(const LAS half8*)(QABS + (fr * 8 + h) * 264 + cs * 32 + fq * 8), *(const half8*)(WUVT + (size_t)(h * 64 + db * 16 + fr) * 256 + cs * 32 + fq * 8), acc);
#pragma unroll
            for (int r = 0; r < 4; ++r) YA[(size_t)(row0 + 4 * fq + r) * 512 + h * 64 + db * 16 + fr] = (h16)acc[r];
        }
    }
    __syncthreads();
}
__device__ __forceinline__ void phase_sattn(const Args& a, LAS unsigned char* lds, int vcu, int G) {
    const int tid = threadIdx.x;
    LAS float* BIAS = (LAS float*)(lds + SA_BIAS); LAS int* BKT = (LAS int*)(lds + SA_BKT);
    if (tid < 256) BIAS[tid] = a.in[17][tid];
    if (tid < 128) { int bk = tid; if (tid >= 16) { bk = 16 + (int)(logf((float)tid * (1.f / 16.f)) / 2.0794415416798357f * 16.f); bk = bk > 31 ? 31 : bk; } BKT[tid] = bk; }
    __syncthreads();
    for (int u = vcu; u < MTOK / 16; u += G) sattn_unit(a, lds, u);
}

__device__ __forceinline__ void mlstmA_unit(const Args& a, LAS unsigned char* lds, int u) {
    const int tid = threadIdx.x, lane = tid & 63, wave = __builtin_amdgcn_readfirstlane(tid >> 6);
    const int fr = lane & 15, fq = lane >> 4;
    const int bh = u >> 7, j = u & 127, b = bh >> 2, h = bh & 3, tpos0 = j * 64; const size_t rowb = (size_t)b * SEQ, r0 = rowb + tpos0;
    const h16* QM = (const h16*)(a.ws + WS_QM); const h16* KM = (const h16*)(a.ws + WS_KM); const h16* VM = (const h16*)(a.ws + WS_VM);
    const float* GI = (const float*)(a.ws + WS_GI); const float* GF = (const float*)(a.ws + WS_GF);
    h16* Q2 = (h16*)(a.ws + WS_Q2); h16* K2 = (h16*)(a.ws + WS_K2); h16* UT = (h16*)(a.ws + WS_UT);
    float* NVEC = (float*)(a.ws + WS_NVEC); float* MLOC = (float*)(a.ws + WS_MLOC); float* BLAST = (float*)(a.ws + WS_BLAST);
    const float* convw = a.in[10]; const float* convb = a.in[11];
    LAS h16* KWT = (LAS h16*)lds; LAS h16* VT = (LAS h16*)(lds + 18432); LAS float* wL = (LAS float*)(lds + 36864);
    if (tid < 64) {
        const int s = tid;
        const float lf = GF[(r0 + s) * 4 + h], ig = GI[(r0 + s) * 4 + h];
        float bs = lf;
#pragma unroll
        for (int off = 1; off < 64; off <<= 1) { const float v = __shfl_up(bs, off); if (lane >= off) bs += v; }
        const float bl = __shfl(bs, 63);
        const float g = bl - bs + ig;
        float ml = g; WAVE_MAX(ml);
        wL[s] = __expf(g - ml);
        if (tid == 0) { MLOC[u] = ml; BLAST[u] = bl; }
    }
    __syncthreads();
#pragma unroll 1
    for (int it = 0; it < 2; ++it) {
        const int p = tid + NTHR * it, s = p >> 4, cg = p & 15, colh = h * 128 + cg * 8;
#pragma unroll
        for (int tz = 0; tz < 2; ++tz) {
            const h16* src = tz ? KM : QM; const int ccol = tz * 512 + colh;
            float acc[8];
#pragma unroll
            for (int i = 0; i < 8; ++i) acc[i] = convb[ccol + i];
#pragma unroll
            for (int w = 0; w < 4; ++w) {
                const int tp = tpos0 + s - 3 + w;
                if (tp >= 0) {
                    const half8 x = *(const half8*)(src + (rowb + tp) * 512 + colh);
#pragma unroll
                    for (int i = 0; i < 8; ++i) acc[i] += convw[w * 1024 + ccol + i] * (float)x[i];
                }
            }
            if (tz == 0) {
#pragma unroll
                for (int i = 0; i < 8; ++i) acc[i] = silu_f(acc[i]);
                *(half8*)(Q2 + (r0 + s) * 512 + colh) = pack8(acc);
            } else {
                const float ws_ = wL[s];
#pragma unroll
                for (int i = 0; i < 8; ++i) acc[i] = silu_f(acc[i]) * 0.08838834764831845f;
                *(half8*)(K2 + (r0 + s) * 512 + colh) = pack8(acc);
#pragma unroll
                for (int i = 0; i < 8; ++i) KWT[(cg * 8 + i) * 72 + s] = (h16)(acc[i] * ws_);
            }
        }
        const half8 v = *(const half8*)(VM + (r0 + s) * 512 + colh);
#pragma unroll
        for (int i = 0; i < 8; ++i) VT[(cg * 8 + i) * 72 + s] = v[i];
    }
    __syncthreads();
    if (tid < 128) {
        float sum = 0.f;
        for (int s = 0; s < 64; ++s) sum += (float)KWT[tid * 72 + s];
        NVEC[(size_t)u * 128 + tid] = sum;
    }
#pragma unroll 2
    for (int db = 0; db < 8; ++db) {
        pg8::f32x4 acc = {0.f, 0.f, 0.f, 0.f};
#pragma unroll
        for (int ks = 0; ks < 2; ++ks) acc = mfma16(*(const LAS half8*)(VT + (wave * 16 + fr) * 72 + ks * 32 + fq * 8), *(const LAS half8*)(KWT + (db * 16 + fr) * 72 + ks * 32 + fq * 8), acc);
#pragma unroll
        for (int r = 0; r < 4; ++r) UT[(size_t)u * 16384 + (wave * 16 + 4 * fq + r) * 128 + db * 16 + fr] = (h16)acc[r];
    }
    __syncthreads();
}

__device__ __forceinline__ void phase_mlstmB(const Args& a, LAS unsigned char* lds, int vcu, int G) {
    const int tid = threadIdx.x;
    const float* MLOC = (const float*)(a.ws + WS_MLOC); const float* BLAST = (const float*)(a.ws + WS_BLAST); const float* NVEC = (const float*)(a.ws + WS_NVEC);
    const h16* UT = (const h16*)(a.ws + WS_UT); h16* CT = (h16*)(a.ws + WS_CT); float* NST = (float*)(a.ws + WS_NST); float* MST = (float*)(a.ws + WS_MST);
    LAS float* decL = (LAS float*)lds; LAS float* sclL = decL + 1024; LAS float* mL = sclL + 1024; LAS float* blL = mL + 1024; LAS float* mlL = blL + 1024;
    for (int i = tid; i < 1024; i += NTHR) { blL[i] = BLAST[i]; mlL[i] = MLOC[i]; }
    __syncthreads();
    if (tid < 8) {
        float m = 0.f;
        for (int j = 0; j < 128; ++j) {
            const float bl = blL[tid * 128 + j], ml = mlL[tid * 128 + j];
            mL[tid * 128 + j] = m;
            const float mn = fmaxf(bl + m, ml);
            decL[tid * 128 + j] = __expf(bl + m - mn); sclL[tid * 128 + j] = __expf(ml - mn); m = mn;
        }
    }
    __syncthreads();
    for (int idx = vcu * NTHR + tid; idx < 8 * 16384; idx += G * NTHR) {
        const int bh = idx >> 14, el = idx & 16383;
        float C = 0.f;
#pragma unroll 8
        for (int j = 0; j < 128; ++j) {
            const size_t off = (size_t)(bh * 128 + j) * 16384 + el;
            CT[off] = (h16)C;
            C = decL[bh * 128 + j] * C + sclL[bh * 128 + j] * (float)UT[off];
        }
    }
    for (int idx = vcu * NTHR + tid; idx < 8 * 128; idx += G * NTHR) {
        const int bh = idx >> 7, d = idx & 127;
        float n = 0.f;
        for (int j = 0; j < 128; ++j) {
            NST[(size_t)(bh * 128 + j) * 128 + d] = n;
            n = decL[bh * 128 + j] * n + sclL[bh * 128 + j] * NVEC[(size_t)(bh * 128 + j) * 128 + d];
            if (d == 0) MST[bh * 128 + j] = mL[bh * 128 + j];
        }
    }
}

constexpr int MC_QL = 0, MC_KL = 17408, MC_VT = 34816, MC_CTL = 53248, MC_PL = 88064, MC_HL = 97280, MC_SM = 131072;
__device__ __forceinline__ void mlstmC_unit(const Args& a, LAS unsigned char* lds, int u) {
    const int tid = threadIdx.x, lane = tid & 63, wave = __builtin_amdgcn_readfirstlane(tid >> 6);
    const int fr = lane & 15, fq = lane >> 4;
    const int bh = u >> 7, j_ = u & 127, b = bh >> 2, h = bh & 3; const size_t r0 = (size_t)b * SEQ + j_ * 64;
    const h16* Q2 = (const h16*)(a.ws + WS_Q2); const h16* K2 = (const h16*)(a.ws + WS_K2); const h16* VM = (const h16*)(a.ws + WS_VM); const h16* CT = (const h16*)(a.ws + WS_CT);
    const float* GI = (const float*)(a.ws + WS_GI); const float* GF = (const float*)(a.ws + WS_GF); const float* NST = (const float*)(a.ws + WS_NST); const float* MST = (const float*)(a.ws + WS_MST);
    const h16* OG = (const h16*)(a.ws + WS_OG); h16* HM = (h16*)(a.ws + WS_HM); const float* hnorm = a.in[16];
    LAS h16* QL = (LAS h16*)(lds + MC_QL); LAS h16* KL = (LAS h16*)(lds + MC_KL); LAS h16* VT = (LAS h16*)(lds + MC_VT); LAS h16* CTL = (LAS h16*)(lds + MC_CTL);
    LAS h16* PL = (LAS h16*)(lds + MC_PL); LAS float* HL = (LAS float*)(lds + MC_HL);
    LAS float* bL = (LAS float*)(lds + MC_SM); LAS float* aL = bL + 64; LAS float* mjL = bL + 128; LAS float* wiL = bL + 192; LAS float* denL = bL + 256; LAS float* nL = bL + 320;
#pragma unroll 1
    for (int it = 0; it < 2; ++it) {
        const int p = tid + NTHR * it, s = p >> 4, cg = p & 15, colh = h * 128 + cg * 8;
        *(LAS half8*)(QL + s * 136 + cg * 8) = *(const half8*)(Q2 + (r0 + s) * 512 + colh);
        *(LAS half8*)(KL + s * 136 + cg * 8) = *(const half8*)(K2 + (r0 + s) * 512 + colh);
        const half8 v = *(const half8*)(VM + (r0 + s) * 512 + colh);
#pragma unroll
        for (int i = 0; i < 8; ++i) VT[(cg * 8 + i) * 72 + s] = v[i];
    }
#pragma unroll 1
    for (int it = 0; it < 4; ++it) {
        const int p = tid + NTHR * it, e = p >> 4, cg = p & 15;
        *(LAS half8*)(CTL + e * 136 + cg * 8) = *(const half8*)(CT + (size_t)u * 16384 + e * 128 + cg * 8);
    }
    if (tid >= 64 && tid < 192) nL[tid - 64] = NST[(size_t)u * 128 + tid - 64];
    if (tid < 64) {
        const int s = tid;
        const float lf = GF[(r0 + s) * 4 + h], ig = GI[(r0 + s) * 4 + h];
        float bs = lf;
#pragma unroll
        for (int off = 1; off < 64; off <<= 1) { const float v = __shfl_up(bs, off); if (lane >= off) bs += v; }
        const float av = ig - bs;
        float cm = av;
#pragma unroll
        for (int off = 1; off < 64; off <<= 1) { const float v = __shfl_up(cm, off); if (lane >= off) cm = fmaxf(cm, v); }
        const float mp = MST[u];
        const float mj = bs + fmaxf(mp, cm);
        bL[s] = bs; aL[s] = av; mjL[s] = mj; wiL[s] = __expf(bs + mp - mj);
    }
    __syncthreads();
    {
        const int jb = wave >> 1;
#pragma unroll
        for (int q2 = 0; q2 < 2; ++q2) {
            const int sb = (wave & 1) * 2 + q2;
            pg8::f32x4 acc = {0.f, 0.f, 0.f, 0.f};
            if (sb <= jb) {
#pragma unroll
                for (int ks = 0; ks < 4; ++ks) acc = mfma16(*(const LAS half8*)(QL + (jb * 16 + fr) * 136 + ks * 32 + fq * 8), *(const LAS half8*)(KL + (sb * 16 + fr) * 136 + ks * 32 + fq * 8), acc);
            }
            const int s = sb * 16 + fr; const float as_ = aL[s];
#pragma unroll
            for (int r = 0; r < 4; ++r) {
                const int jj = jb * 16 + 4 * fq + r;
                const float pv = (s <= jj) ? acc[r] * __expf(bL[jj] - mjL[jj] + as_) : 0.f;
                PL[jj * 72 + s] = (h16)pv;
            }
        }
    }
    __syncthreads();
    {
        const int jb = wave >> 1;
#pragma unroll 1
        for (int e4 = 0; e4 < 4; ++e4) {
            const int eb = (wave & 1) * 4 + e4;
            pg8::f32x4 a1 = {0.f, 0.f, 0.f, 0.f}, a2 = {0.f, 0.f, 0.f, 0.f};
#pragma unroll
            for (int ks = 0; ks < 4; ++ks) a1 = mfma16(*(const LAS half8*)(QL + (jb * 16 + fr) * 136 + ks * 32 + fq * 8), *(const LAS half8*)(CTL + (eb * 16 + fr) * 136 + ks * 32 + fq * 8), a1);
#pragma unroll
            for (int ks = 0; ks < 2; ++ks) a2 = mfma16(*(const LAS half8*)(PL + (jb * 16 + fr) * 72 + ks * 32 + fq * 8), *(const LAS half8*)(VT + (eb * 16 + fr) * 72 + ks * 32 + fq * 8), a2);
#pragma unroll
            for (int r = 0; r < 4; ++r) { const int jj = jb * 16 + 4 * fq + r; HL[jj * 132 + eb * 16 + fr] = wiL[jj] * a1[r] + a2[r]; }
        }
        const int jj = tid >> 3, part = tid & 7;
        float qn = 0.f, ps = 0.f;
#pragma unroll
        for (int d = 0; d < 16; ++d) qn += (float)QL[jj * 136 + part * 16 + d] * nL[part * 16 + d];
#pragma unroll
        for (int s = 0; s < 8; ++s) ps += (float)PL[jj * 72 + part * 8 + s];
        qn += __shfl_xor(qn, 1); qn += __shfl_xor(qn, 2); qn += __shfl_xor(qn, 4);
        ps += __shfl_xor(ps, 1); ps += __shfl_xor(ps, 2); ps += __shfl_xor(ps, 4);
        if (part == 0) denL[jj] = wiL[jj] * qn + ps;
    }
    __syncthreads();
#pragma unroll 1
    for (int rr = 0; rr < 8; ++rr) {
        const int jj = wave * 8 + rr;
        const float dn = fmaxf(fabsf(denL[jj]), __expf(-mjL[jj]));
        const float h0 = HL[jj * 132 + lane] / dn, h1 = HL[jj * 132 + 64 + lane] / dn;
        float sm = h0 + h1; WAVE_SUM(sm);
        const float mean = sm * (1.f / 128.f), d0 = h0 - mean, d1 = h1 - mean;
        float vs = d0 * d0 + d1 * d1; WAVE_SUM(vs);
        const float rs = 1.0f / sqrtf(vs * (1.f / 128.f) + EPS);
        const size_t o = (r0 + jj) * 512 + h * 128;
        HM[o + lane] = (h16)(d0 * rs * hnorm[h * 128 + lane] * (float)OG[o + lane]);
        HM[o + 64 + lane] = (h16)(d1 * rs * hnorm[h * 128 + 64 + lane] * (float)OG[o + 64 + lane]);
    }
    __syncthreads();
}

#ifndef MK_SPLIT
#define MK_SPLIT 0
#endif
constexpr int NPHASE = 15;
__global__ void __launch_bounds__(NTHR, 2) hybrid_fwd(Args args) {
    extern __shared__ __attribute__((aligned(16))) unsigned char lds_raw[];
    LAS unsigned char* lds = (LAS unsigned char*)lds_raw;
    const int tid = threadIdx.x;
    const int G = gridDim.x; const int bx = blockIdx.x; const int vcu = (G % 8 == 0) ? (bx % 8) * (G / 8) + bx / 8 : bx;
    volatile LAS unsigned* MISC = (volatile LAS unsigned*)(lds + MISC_OFF);
    if (tid < 64) ((LAS unsigned*)(lds + MISC_OFF))[tid] = 0u;
    __syncthreads();
    unsigned char* ws = args.ws;
    gu32* ctl = (gu32*)(ws + WS_CTL);
    XcdBarrier bar; bar.bar = (unsigned*)(ctl + CW_BAR); bar.x = 0; bar.st = nullptr;
    if (!MK_SPLIT) bar = xcd_barrier_post((unsigned*)(ctl + CW_BAR), MISC + 8);
    const int lo = args.ph_lo, hi = args.ph_hi;
#define IN(k) (lo <= (k) && (k) < hi)
#define SEAM(k) do { if (IN(k) && IN((k) + 1)) xcd_barrier(bar); } while (0)
    float* xres = args.out;
    const float* MOD = (const float*)(ws + WS_MOD);
    h16* XN = (h16*)(ws + WS_XN); h16* HID = (h16*)(ws + WS_HID);

    if (IN(0)) { phase_prologue(args, lds, vcu, G); } SEAM(0);
    if (IN(1)) { phase_norm<0>(args, lds, vcu, G, args.in[0], args.in[4], 0, XN, nullptr); } SEAM(1);
    if (IN(2)) {
        pg8::Gemm g{(const pg8::bf16_t*)XN, (const pg8::bf16_t*)(ws + WS_W13A), MTOK, 2 * DFF, DM}; pg8::StaticOrder S; S.init(MTOK, 2 * DFF, G, bx);
        EpiSwiGLU E{HID};
        pg8::gemm_phase<EpiSwiGLU, pg8::StaticOrder, true, true>(lds, g, S, E);
    } SEAM(2);
    if (IN(3)) {
        pg8::Gemm g{(const pg8::bf16_t*)HID, (const pg8::bf16_t*)(ws + WS_W2A), MTOK, DM, DFF}; pg8::StaticOrder S; S.init(MTOK, DM, G, bx);
        EpiResid E{args.in[0], xres, MOD + 2 * 1024, 0.5f};
        pg8::gemm_phase<EpiResid, pg8::StaticOrder, true, true>(lds, g, S, E);
    } SEAM(3);
    if (IN(4)) { phase_norm<1>(args, lds, vcu, G, xres, args.in[8], 3, XN, nullptr); } SEAM(4);
    if (IN(5)) {
        pg8::Gemm g{(const pg8::bf16_t*)XN, (const pg8::bf16_t*)(ws + WS_WIN), MTOK, NWIN, DM}; pg8::StaticOrder S; S.init(MTOK, NWIN, G, bx);
        EpiWin E{ws, args.in[15]};
        pg8::gemm_phase<EpiWin, pg8::StaticOrder, true, true>(lds, g, S, E);
    } SEAM(5);
    if (IN(6)) {
        kv_finalize(args, vcu, G);
        phase_indexer(args, lds, vcu, G);
        for (int u = vcu; u < 1024; u += G) mlstmA_unit(args, lds, u);
    } SEAM(6);
    if (IN(7)) {
        phase_sattn(args, lds, vcu, G);
        phase_mlstmB(args, lds, vcu, G);
    } SEAM(7);
    if (IN(8)) { for (int u = vcu; u < 1024; u += G) mlstmC_unit(args, lds, u); } SEAM(8);
    if (IN(9)) {
        pg8::StaticOrder S; S.init(MTOK, DM, G, bx);
        { pg8::Gemm g{(const pg8::bf16_t*)(ws + WS_YA), (const pg8::bf16_t*)(ws + WS_WBA), MTOK, DM, 512};
          EpiMerge<false> E{(const h16*)(ws + WS_GA), (h16*)(ws + WS_MRG)};
          pg8::gemm_phase<EpiMerge<false>, pg8::StaticOrder, true, true>(lds, g, S, E); }
        __syncthreads();
        { pg8::Gemm g{(const pg8::bf16_t*)(ws + WS_HM), (const pg8::bf16_t*)(ws + WS_WBM), MTOK, DM, 512};
          EpiMerge<true> E{(const h16*)(ws + WS_GM), (h16*)(ws + WS_MRG)};
          pg8::gemm_phase<EpiMerge<true>, pg8::StaticOrder, true, true>(lds, g, S, E); }
    } SEAM(9);
    if (IN(10)) {
        pg8::Gemm g{(const pg8::bf16_t*)(ws + WS_MRG), (const pg8::bf16_t*)(ws + WS_WOUT), MTOK, DM, DM}; pg8::StaticOrder S; S.init(MTOK, DM, G, bx);
        EpiResid E{xres, xres, MOD + 5 * 1024, 1.0f};
        pg8::gemm_phase<EpiResid, pg8::StaticOrder, true, true>(lds, g, S, E);
    } SEAM(10);
    if (IN(11)) { phase_norm<1>(args, lds, vcu, G, xres, args.in[21], 6, XN, nullptr); convert_ffn2_weights(args, lds, vcu, G); } SEAM(11);
    if (IN(12)) {
        pg8::Gemm g{(const pg8::bf16_t*)XN, (const pg8::bf16_t*)(ws + WS_W13B), MTOK, 2 * DFF, DM}; pg8::StaticOrder S; S.init(MTOK, 2 * DFF, G, bx);
        EpiSwiGLU E{HID};
        pg8::gemm_phase<EpiSwiGLU, pg8::StaticOrder, true, true>(lds, g, S, E);
    } SEAM(12);
    if (IN(13)) {
        pg8::Gemm g{(const pg8::bf16_t*)HID, (const pg8::bf16_t*)(ws + WS_W2B), MTOK, DM, DFF}; pg8::StaticOrder S; S.init(MTOK, DM, G, bx);
        EpiResid E{xres, xres, MOD + 8 * 1024, 0.5f};
        pg8::gemm_phase<EpiResid, pg8::StaticOrder, true, true>(lds, g, S, E);
    } SEAM(13);
    if (IN(14)) { phase_norm<2>(args, lds, vcu, G, xres, args.in[25], 0, nullptr, xres); }
#undef IN
#undef SEAM
}

extern "C" void kernel_launch(void* const* d_in, const int* in_sizes, int n_in, void* d_out, int out_size, void* d_ws, size_t ws_size, hipStream_t stream) {
    static int grid = 0;
    if (grid == 0) {
        if (n_in != 26 || out_size != MTOK * DM || ws_size < WS_END) { fprintf(stderr, "kernel_launch: unexpected shapes (n_in %d out %d ws %zu)\n", n_in, out_size, ws_size); grid = -1; return; }
        int dev = 0, cus = 0, per_cu = 0;
        if (hipGetDevice(&dev) != hipSuccess || hipDeviceGetAttribute(&cus, hipDeviceAttributeMultiprocessorCount, dev) != hipSuccess) { grid = -1; return; }
        if (hipFuncSetAttribute((const void*)hybrid_fwd, hipFuncAttributeMaxDynamicSharedMemorySize, LDS_BYTES) != hipSuccess) { fprintf(stderr, "kernel_launch: hipFuncSetAttribute failed\n"); grid = -1; return; }
        if (hipOccupancyMaxActiveBlocksPerMultiprocessor(&per_cu, (const void*)hybrid_fwd, NTHR, LDS_BYTES) != hipSuccess || per_cu < 1) { fprintf(stderr, "kernel_launch: occupancy query says %d blocks per CU\n", per_cu); per_cu = 1; }
        (void)hipGetLastError();
        grid = cus;
    }
    if (grid < 0) return;
    (void)hipMemsetAsync((char*)d_ws + WS_CTL, 0, CTL_ZERO_BYTES, stream);
    Args a{};
    for (int i = 0; i < 26; ++i) a.in[i] = (const float*)d_in[i];
    a.out = (float*)d_out; a.ws = (unsigned char*)d_ws;
#if MK_SPLIT
    for (int p = 0; p < NPHASE; ++p) { a.ph_lo = p; a.ph_hi = p + 1; hipLaunchKernelGGL(hybrid_fwd, dim3(grid), dim3(NTHR), LDS_BYTES, stream, a); }
#else
    a.ph_lo = 0; a.ph_hi = NPHASE;
    hipLaunchKernelGGL(hybrid_fwd, dim3(grid), dim3(NTHR), LDS_BYTES, stream, a);
#endif
}
```

```cpp
#include <hip/hip_runtime.h>
#include <cstdio>
#include <cstdint>
#include <cmath>
typedef _Float16 h16;
typedef _Float16 half8 __attribute__((ext_vector_type(8)));
typedef _Float16 half4 __attribute__((ext_vector_type(4)));
namespace pg8 {
typedef _Float16 half8 __attribute__((ext_vector_type(8)));
#define PG8_LAS __attribute__((address_space(3)))
typedef unsigned short bf16_t;
typedef short bf16x8 __attribute__((ext_vector_type(8)));
typedef float f32x4 __attribute__((ext_vector_type(4)));
typedef unsigned u32x4 __attribute__((ext_vector_type(4)));
constexpr int BM = 256, BK = 64, HALF = 128, HTB = HALF * BK * 2  , STAGE_BYTES = 8 * HTB, NXCD = 8, WGM = 8;

__host__ __device__ __forceinline__ int lds_byte(int r, int c) { const int st = (r >> 4) * 2 + (c >> 5), rr = r & 15, cc = c & 31, ob = rr * 64 + cc * 2; return st * 1024 + (ob ^ (((ob >> 9) & 1) << 5)); }
__host__ __device__ __forceinline__ void stage_rc(int b, int& R, int& C) { const int st = b / 1024, sb = b % 1024, swz = sb ^ (((sb >> 9) & 1) << 5); R = (st >> 1) * 16 + swz / 64; C = (st & 1) * 32 + (swz % 64) / 2; }
__host__ __device__ __forceinline__ int perm32(int rho) { const int n = rho >> 4, i = rho & 15; return 8 * (i >> 2) + 4 * n + (i & 3); }

struct Unit { int pm, pn; };
struct Gemm { const bf16_t* A; const bf16_t* Bt; int M, N, K; };

struct StaticOrder {
    int nM, nN, nwg, G, c;
    __host__ __device__ void init(int M, int N, int G_, int c_) { nM = M / BM; nN = N / BM; nwg = nM * nN; G = G_; c = c_; }
    __host__ __device__ bool next(int i, Unit& u) const {
        const long L = (long)i * G + c; if (L >= nwg) return false;
        int wgid = (int)L; { const int q = nwg / NXCD, r = nwg % NXCD, xcd = wgid % NXCD, off = wgid / NXCD; wgid = (xcd < r ? xcd * (q + 1) : r * (q + 1) + (xcd - r) * q) + off; }
        const int nig = WGM * nN, gid = wgid / nig, fm = gid * WGM, gsz = (nM - fm) < WGM ? (nM - fm) : WGM;
        u.pm = fm + ((wgid % nig) % gsz); u.pn = (wgid % nig) / gsz; return true;
    }
    __device__ __forceinline__ void a_ready(const Unit&) const {}
    __device__ __forceinline__ void done(const Unit&) const {}
};
template <class Epi, class Sched, bool ALIGN_EPI = false, bool SP2 = false>
__device__ __forceinline__ void gemm_phase(PG8_LAS unsigned char* lds, const Gemm g, const Sched& S, const Epi& E) {
    const int tid = threadIdx.x, wid = __builtin_amdgcn_readfirstlane(tid >> 6), lane = tid & 63, wr = wid >> 2, wc = wid & 3, fr = lane & 15, fq = lane >> 4;
    const int K = g.K, nt = K / BK;
    unsigned voffA[2], voffB[2];
#pragma unroll
    for (int i = 0; i < 2; ++i) { int R, C; stage_rc(tid * 16 + i * 8192, R, C); const int Rb = Epi::PERM ? ((R & ~31) + perm32(R & 31)) : R;
        voffA[i] = (unsigned)(R * K + C) * 2u; voffB[i] = (unsigned)(Rb * K + C) * 2u; }
    const size_t kstep = (size_t)(BK * 2);
    const size_t hstep = (size_t)HALF * K * 2;
    const size_t tstep = 2 * hstep;
    const unsigned ldsw = (unsigned)wid * 1024u;
    const int aoff = lds_byte(wr * 64 + fr, fq * 8), boff = lds_byte(wc * 32 + fr, fq * 8);
#define PG8_SA(b, h) (((b) * 2 + (h)) * HTB)
#define PG8_SB(b, h) ((4 + (b) * 2 + (h)) * HTB)
#define PG8_STAGE(bufoff, gbase, voff) do { _Pragma("unroll") for (int _i = 0; _i < 2; ++_i) \
        __builtin_amdgcn_global_load_lds((const unsigned*)((const char*)(gbase) + (voff)[_i]), (PG8_LAS unsigned*)(lds + (bufoff) + ldsw + _i * 8192), 16, 0, 0); } while (0)
#define PG8_LDA(dst, b, h) do { _Pragma("unroll") for (int m = 0; m < 4; ++m) _Pragma("unroll") for (int k = 0; k < 2; ++k) dst[m][k] = *(const PG8_LAS bf16x8*)(lds + PG8_SA(b, h) + aoff + m * 2048 + k * 1024); } while (0)
#define PG8_LDB(dst, b, h) do { _Pragma("unroll") for (int n = 0; n < 2; ++n) _Pragma("unroll") for (int k = 0; k < 2; ++k) dst[n][k] = *(const PG8_LAS bf16x8*)(lds + PG8_SB(b, h) + boff + n * 2048 + k * 1024); } while (0)
#define PG8_MMA(ai, bj, At, Bt) do { __builtin_amdgcn_s_setprio(1); _Pragma("unroll") for (int m = 0; m < 4; ++m) _Pragma("unroll") for (int n = 0; n < 2; ++n) _Pragma("unroll") for (int k = 0; k < 2; ++k) \
        acc[ai][bj][m][n] = __builtin_amdgcn_mfma_f32_16x16x32_f16(__builtin_bit_cast(half8, Bt[n][k]), __builtin_bit_cast(half8, At[m][k]), acc[ai][bj][m][n], 0, 0, 0); __builtin_amdgcn_s_setprio(0); } while (0)
#define PG8_WAIT_V(n) asm volatile("s_waitcnt vmcnt(" #n ")" ::: "memory")
#define PG8_WAIT_L(n) asm volatile("s_waitcnt lgkmcnt(" #n ")" ::: "memory")
#define PG8_BAR __builtin_amdgcn_s_barrier()
#define PG8_SCHED __builtin_amdgcn_sched_barrier(0)
    Unit cur, nxt; int ui = 0;
    if (!S.next(0, cur)) return;
    f32x4 acc[2][2][4][2];
#pragma unroll
    for (int a = 0; a < 2; ++a)
#pragma unroll
        for (int b = 0; b < 2; ++b)
#pragma unroll
            for (int m = 0; m < 4; ++m)
#pragma unroll
                for (int n = 0; n < 2; ++n) acc[a][b][m][n] = (f32x4){0.f, 0.f, 0.f, 0.f};
    bf16x8 At[4][2], B0[2][2], B1[2][2];
    const char* cA = (const char*)g.A + (size_t)cur.pm * tstep; const char* cB = (const char*)g.Bt + (size_t)cur.pn * tstep;
    S.a_ready(cur);
    if constexpr (SP2) {
        PG8_STAGE(PG8_SB(0, 0), cB, voffB); PG8_STAGE(PG8_SB(0, 1), cB + hstep, voffB); PG8_STAGE(PG8_SA(0, 0), cA, voffA); PG8_STAGE(PG8_SA(0, 1), cA + hstep, voffA);
        if (wr == 1) PG8_BAR;
        PG8_WAIT_V(2); PG8_BAR;
        PG8_STAGE(PG8_SB(1, 0), cB + kstep, voffB); PG8_STAGE(PG8_SA(1, 0), cA + kstep, voffA); PG8_STAGE(PG8_SB(1, 1), cB + hstep + kstep, voffB);
        PG8_WAIT_V(6); PG8_BAR;
    } else {
        PG8_STAGE(PG8_SB(0, 0), cB, voffB); PG8_STAGE(PG8_SA(0, 0), cA, voffA); PG8_STAGE(PG8_SB(0, 1), cB + hstep, voffB); PG8_STAGE(PG8_SA(0, 1), cA + hstep, voffA);
        if (wr == 1) PG8_BAR;
        PG8_WAIT_V(4); PG8_BAR;
        PG8_STAGE(PG8_SB(1, 0), cB + kstep, voffB); PG8_STAGE(PG8_SA(1, 0), cA + kstep, voffA); PG8_STAGE(PG8_SB(1, 1), cB + hstep + kstep, voffB);
        PG8_WAIT_V(6); PG8_BAR;
    }
    for (;;) {
        const bool has_next = S.next(ui + 1, nxt);
        const char* nA = has_next ? (const char*)g.A + (size_t)nxt.pm * tstep : cA; const char* nB = has_next ? (const char*)g.Bt + (size_t)nxt.pn * tstep : cB;
        for (int t = 0; t < nt; t += 2) {
            const bool last = (t == nt - 2);
            const char* a1 = cA + (size_t)(t + 1) * kstep;
            const char* a2 = last ? nA : cA + (size_t)(t + 2) * kstep; const char* b2 = last ? nB : cB + (size_t)(t + 2) * kstep;
            const char* a3 = a2 + kstep; const char* b3 = b2 + kstep;
            if (last && has_next) S.a_ready(nxt);
            if constexpr (SP2) {
            PG8_LDB(B0, 0, 0); PG8_LDB(B1, 0, 1); PG8_SCHED; PG8_LDA(At, 0, 0); PG8_STAGE(PG8_SA(1, 1), a1 + hstep, voffA);
            PG8_WAIT_V(8); PG8_WAIT_L(0); PG8_BAR; PG8_MMA(0, 0, At, B0); PG8_MMA(0, 1, At, B1); PG8_BAR; PG8_SCHED;
            PG8_LDA(At, 0, 1); PG8_STAGE(PG8_SB(0, 0), b2, voffB); PG8_STAGE(PG8_SB(0, 1), b2 + hstep, voffB); PG8_STAGE(PG8_SA(0, 0), a2, voffA);
            PG8_WAIT_V(8); PG8_WAIT_L(0); PG8_BAR; PG8_MMA(1, 0, At, B0); PG8_MMA(1, 1, At, B1); PG8_BAR; PG8_SCHED;
            PG8_LDB(B0, 1, 0); PG8_LDB(B1, 1, 1); PG8_SCHED; PG8_LDA(At, 1, 0); PG8_STAGE(PG8_SA(0, 1), a2 + hstep, voffA);
            PG8_WAIT_V(8); PG8_WAIT_L(0); PG8_BAR; PG8_MMA(0, 0, At, B0); PG8_MMA(0, 1, At, B1); PG8_BAR; PG8_SCHED;
            PG8_LDA(At, 1, 1); PG8_STAGE(PG8_SB(1, 0), b3, voffB); PG8_STAGE(PG8_SB(1, 1), b3 + hstep, voffB); PG8_STAGE(PG8_SA(1, 0), a3, voffA);
            PG8_WAIT_V(8); PG8_WAIT_L(0); PG8_BAR; PG8_MMA(1, 0, At, B0); PG8_MMA(1, 1, At, B1); PG8_BAR; PG8_SCHED;
            } else {
            PG8_LDB(B0, 0, 0); PG8_SCHED; PG8_LDA(At, 0, 0); PG8_STAGE(PG8_SA(1, 1), a1 + hstep, voffA);
            PG8_WAIT_L(8); PG8_BAR; PG8_WAIT_L(0); PG8_MMA(0, 0, At, B0); PG8_BAR; PG8_SCHED;
            PG8_LDB(B1, 0, 1); PG8_STAGE(PG8_SB(0, 0), b2, voffB);
            PG8_BAR; PG8_WAIT_L(0); PG8_MMA(0, 1, At, B1); PG8_BAR;
            PG8_LDA(At, 0, 1); PG8_STAGE(PG8_SA(0, 0), a2, voffA);
            PG8_BAR; PG8_WAIT_L(0); PG8_MMA(1, 0, At, B0); PG8_BAR; PG8_SCHED;
            PG8_STAGE(PG8_SB(0, 1), b2 + hstep, voffB);
            PG8_WAIT_V(6); PG8_BAR; PG8_MMA(1, 1, At, B1); PG8_BAR;
            PG8_LDB(B0, 1, 0); PG8_SCHED; PG8_LDA(At, 1, 0); PG8_STAGE(PG8_SA(0, 1), a2 + hstep, voffA);
            PG8_WAIT_L(8); PG8_BAR; PG8_WAIT_L(0); PG8_MMA(0, 0, At, B0); PG8_BAR; PG8_SCHED;
            PG8_LDB(B1, 1, 1); PG8_STAGE(PG8_SB(1, 0), b3, voffB);
            PG8_BAR; PG8_WAIT_L(0); PG8_MMA(0, 1, At, B1); PG8_BAR;
            PG8_LDA(At, 1, 1); PG8_STAGE(PG8_SA(1, 0), a3, voffA);
            PG8_BAR; PG8_WAIT_L(0); PG8_MMA(1, 0, At, B0); PG8_BAR; PG8_SCHED;
            PG8_STAGE(PG8_SB(1, 1), b3 + hstep, voffB);
            PG8_WAIT_V(6); PG8_BAR; PG8_MMA(1, 1, At, B1); PG8_BAR;
            }
        }
        if constexpr (ALIGN_EPI) { if (wr == 0) PG8_BAR; }
        if constexpr (!Epi::AFTER_DRAIN) { E(acc, cur, wr, wc, fr, fq); S.done(cur); }
        if (!has_next) break;
#pragma unroll
        for (int a = 0; a < 2; ++a)
#pragma unroll
            for (int b = 0; b < 2; ++b)
#pragma unroll
                for (int m = 0; m < 4; ++m)
#pragma unroll
                    for (int n = 0; n < 2; ++n) acc[a][b][m][n] = (f32x4){0.f, 0.f, 0.f, 0.f};
        cur = nxt; cA = nA; cB = nB; ++ui;
        if constexpr (ALIGN_EPI) { if (wr == 1) PG8_BAR; }
    }
    PG8_WAIT_V(0);
    if constexpr (!ALIGN_EPI) { if (wr == 0) PG8_BAR; }
    PG8_BAR;
    if constexpr (Epi::AFTER_DRAIN) { E.fused(acc, cur, wr, wc, fr, fq, lds, wid, lane); S.done(cur); }
#undef PG8_SA
#undef PG8_SB
#undef PG8_STAGE
#undef PG8_LDA
#undef PG8_LDB
#undef PG8_MMA
#undef PG8_WAIT_V
#undef PG8_WAIT_L
#undef PG8_BAR
#undef PG8_SCHED
}
}
#define GAS __attribute__((address_space(1)))
#define LAS __attribute__((address_space(3)))
typedef unsigned short bf16;
typedef unsigned v4u __attribute__((ext_vector_type(4)));
typedef float f32x4 __attribute__((ext_vector_type(4)));
typedef short bf16x8 __attribute__((ext_vector_type(8)));
typedef GAS unsigned gu32;
typedef GAS unsigned long long gu64;
#define RLX_AGENT __ATOMIC_RELAXED, __HIP_MEMORY_SCOPE_AGENT
#define LDS_WAIT() asm volatile("s_waitcnt lgkmcnt(0)" ::: "memory")
#define VM_WAIT() asm volatile("s_waitcnt vmcnt(0)" ::: "memory")
__device__ __forceinline__ unsigned long long rt() { return __builtin_amdgcn_s_memrealtime(); }
__device__ __forceinline__ unsigned f2bf(float f) { unsigned u = __builtin_bit_cast(unsigned, f); return (u + 0x7fffu + ((u >> 16) & 1u)) >> 16; }
__device__ __forceinline__ unsigned pk2(float lo, float hi) { return f2bf(lo) | (f2bf(hi) << 16); }

#define XB_TMO      128
#define XB_XCNT(j)  (256  + 64 * (j))
#define XB_XSUB(j)  (1280 + 64 * (j))
#define XB_XGEN(j)  (2304 + 64 * (j))
#define XB_TOP      3328
#define XB_TOPGEN   3392
#define XCD_BAR_WORDS 3456
#define XB_SPIN_CAP (1u << 18)

__device__ __forceinline__ unsigned xb_ld(unsigned* p)              { return __hip_atomic_load(p, __ATOMIC_RELAXED, __HIP_MEMORY_SCOPE_AGENT); }
__device__ __forceinline__ unsigned xb_add(unsigned* p, unsigned v) { return __hip_atomic_fetch_add(p, v, __ATOMIC_RELAXED, __HIP_MEMORY_SCOPE_AGENT); }
__device__ __forceinline__ unsigned xb_xcc_id() { return (unsigned)__builtin_amdgcn_s_getreg((3 << 11) | 20) & 0xFu; }
#define XB_SPIN(cond, bar) do { unsigned _sp = 0; while (cond) { __builtin_amdgcn_s_sleep(1); \
    if ((++_sp & 255u) == 0u) { if (xb_ld(&(bar)[XB_TMO])) break; if (_sp > XB_SPIN_CAP) { atomicAdd(&(bar)[XB_TMO], 1u); break; } } } } while (0)

struct XcdBarrier {
    unsigned* bar; unsigned x;
    volatile LAS unsigned* st;
};

__device__ __forceinline__ XcdBarrier xcd_barrier_post(unsigned* bar, volatile LAS unsigned* st) {
    XcdBarrier b; b.bar = bar; b.x = xb_xcc_id(); b.st = st;
    if (threadIdx.x == 0) (void)xb_add(&bar[XB_XCNT(b.x)], 1u);
    return b;
}
__device__ __forceinline__ void xcd_barrier_complete(unsigned* bar, unsigned x, unsigned& nloc, unsigned& nx) {
    const unsigned G = gridDim.x * gridDim.y * gridDim.z;
    unsigned sum, cnt, mine, sp = 0u;
    for (;;) {
        sum = 0u; cnt = 0u; mine = 0u;
#pragma unroll
        for (unsigned j = 0; j < 16; ++j) { const unsigned c = xb_ld(&bar[XB_XCNT(j)]); sum += c; cnt += (c > 0u) ? 1u : 0u; mine = (j == x) ? c : mine; }
        if (sum == G) break;
        __builtin_amdgcn_s_sleep(1);
        if ((++sp & 255u) == 0u) { if (xb_ld(&bar[XB_TMO])) break; if (sp > XB_SPIN_CAP) { atomicAdd(&bar[XB_TMO], 1u); break; } }
    }
    nloc = mine > 0u ? mine : 1u; nx = cnt > 0u ? cnt : 1u;
}

__device__ __forceinline__ void xcd_barrier(const XcdBarrier& b) {
    asm volatile("s_waitcnt vmcnt(0)" ::: "memory");
    __syncthreads();
    if (threadIdx.x == 0) {
        unsigned* bar = b.bar;
        __builtin_amdgcn_s_waitcnt(0);
        unsigned nloc = b.st[0], nx = b.st[1];
        if (nloc == 0u) { xcd_barrier_complete(bar, b.x, nloc, nx); b.st[0] = nloc; b.st[1] = nx; }
        const unsigned old = xb_add(&bar[XB_XSUB(b.x)], 1u);
        const unsigned gen = old / nloc;
        if (old + 1u == (gen + 1u) * nloc) {
            __builtin_amdgcn_fence(__ATOMIC_RELEASE, "agent");
            asm volatile("s_waitcnt vmcnt(0)" ::: "memory");
            const unsigned og = xb_add(&bar[XB_TOP], 1u);
            const unsigned tg = og / nx;
            if (og + 1u == (tg + 1u) * nx) xb_add(&bar[XB_TOPGEN], 1u);
            else XB_SPIN(xb_ld(&bar[XB_TOPGEN]) == tg, bar);
            __builtin_amdgcn_fence(__ATOMIC_ACQUIRE, "agent");
            xb_add(&bar[XB_XGEN(b.x)], 1u);
            asm volatile("s_waitcnt vmcnt(0)" ::: "memory");
        } else {
            XB_SPIN(xb_ld(&bar[XB_XGEN(b.x)]) == gen, bar);
            __builtin_amdgcn_fence(__ATOMIC_ACQUIRE, "agent");
            asm volatile("s_waitcnt vmcnt(0)" ::: "memory");
        }
    }
    __syncthreads();
}

constexpr int BATCH = 2, SEQ = 8192, DM = 1024, MTOK = BATCH * SEQ;
constexpr int DLAT = 256, TOPK = 256, DFF = 2816, DIN = 5456, NWIN = 5632;
constexpr int NWAVES = 8, NTHR = 512;
constexpr float EPS = 1e-6f;
constexpr float IDX_SCALE = 0.04419417382415922f;
constexpr int NKS = 16;

constexpr size_t MiB = 1u << 20;
constexpr size_t WS_CTL = 0, CTL_ZERO_BYTES = 1 * MiB;
constexpr size_t WS_W13A = 1 * MiB;
constexpr size_t WS_W2A  = 12 * MiB;
constexpr size_t WS_WIN  = 18 * MiB;
constexpr size_t WS_WBA  = 29 * MiB;
constexpr size_t WS_WBM  = 30 * MiB;
constexpr size_t WS_WOUT = 31 * MiB;
constexpr size_t WS_WUK  = 33 * MiB;
constexpr size_t WS_WUVT = 33 * MiB + 256 * 1024;
constexpr size_t WS_MODP = 33 * MiB + 512 * 1024;
constexpr size_t WS_MOD  = 34 * MiB + 768 * 1024;
constexpr size_t WS_XN   = 35 * MiB;
constexpr size_t WS_HID  = 67 * MiB;
constexpr size_t WS_QA   = 67 * MiB;
constexpr size_t WS_CKV  = 83 * MiB;
constexpr size_t WS_QIDX = 91 * MiB;
constexpr size_t WS_KIDX = 107 * MiB;
constexpr size_t WS_WIDX = 109 * MiB;
constexpr size_t WS_GI   = 109 * MiB + 512 * 1024;
constexpr size_t WS_GF   = 109 * MiB + 768 * 1024;
constexpr size_t WS_QM   = 110 * MiB;
constexpr size_t WS_KM   = 126 * MiB;
constexpr size_t WS_VM   = 142 * MiB;
constexpr size_t WS_OG   = 158 * MiB;
constexpr size_t WS_GA   = 174 * MiB;
constexpr size_t WS_GM   = 206 * MiB;
constexpr size_t WS_Q2   = 238 * MiB;
constexpr size_t WS_SEL  = 1 * MiB;
constexpr size_t WS_K2   = 9 * MiB;
constexpr size_t WS_NVEC = 25 * MiB;
constexpr size_t WS_MLOC = 25 * MiB + 512 * 1024;
constexpr size_t WS_BLAST= 25 * MiB + 520 * 1024;
constexpr size_t WS_NST  = 26 * MiB;
constexpr size_t WS_MST  = 26 * MiB + 512 * 1024;
constexpr size_t WS_UT   = 35 * MiB;
constexpr size_t WS_YA   = 91 * MiB;
constexpr size_t WS_CT   = 110 * MiB;
constexpr size_t WS_HM   = 35 * MiB;
constexpr size_t WS_MRG  = 110 * MiB;
constexpr size_t WS_W13B = 1 * MiB;
constexpr size_t WS_W2B  = 12 * MiB;
constexpr size_t WS_END  = 256 * MiB;

constexpr int CW_BAR = 4096;

constexpr int LDS_BYTES = 160 * 1024;
constexpr int MISC_OFF = LDS_BYTES - 256;

#define WAVE_SUM(v) do { _Pragma("unroll") for (int _o = 1; _o < 64; _o <<= 1) v += __shfl_xor(v, _o); } while (0)
#define WAVE_MAX(v) do { _Pragma("unroll") for (int _o = 1; _o < 64; _o <<= 1) v = fmaxf(v, __shfl_xor(v, _o)); } while (0)

typedef unsigned u32x4 __attribute__((ext_vector_type(4)));
typedef unsigned u32x2 __attribute__((ext_vector_type(2)));

__device__ __forceinline__ float silu_f(float a) { return a * __builtin_amdgcn_rcpf(1.f + __expf(-a)); }
__device__ __forceinline__ float sigmoid_f(float a) { return __builtin_amdgcn_rcpf(1.f + __expf(-a)); }
__device__ __forceinline__ float logsigmoid_f(float x) { return fminf(x, 0.f) - log1pf(__expf(-fabsf(x))); }
__device__ __forceinline__ half8 pack8(const float* v) { half8 r; _Pragma("unroll") for (int i = 0; i < 8; ++i) r[i] = (h16)v[i]; return r; }
__device__ __forceinline__ f32x4 mfma16(half8 a, half8 b, f32x4 c) { return __builtin_amdgcn_mfma_f32_16x16x32_f16(a, b, c, 0, 0, 0); }

struct Args { const float* in[26]; float* out; unsigned char* ws; int ph_lo, ph_hi; };

struct EpiSwiGLU {
    static constexpr bool PERM = true, AFTER_DRAIN = false;
    h16* O;
    __device__ __forceinline__ void operator()(const pg8::f32x4 (&acc)[2][2][4][2], const pg8::Unit& u, int wr, int wc, int fr, int fq) const {
        const int row0 = u.pm * 256 + wr * 64 + fr, col0 = u.pn * 128 + wc * 32 + 8 * fq;
#pragma unroll
        for (int ai = 0; ai < 2; ++ai)
#pragma unroll
            for (int m = 0; m < 4; ++m) {
                h16* rowp = O + (size_t)(row0 + ai * 128 + m * 16) * DFF + col0;
                float r[8];
#pragma unroll
                for (int n = 0; n < 2; ++n)
#pragma unroll
                    for (int i = 0; i < 4; ++i) r[n * 4 + i] = silu_f(acc[ai][0][m][n][i]) * acc[ai][1][m][n][i];
                *(half8*)rowp = pack8(r);
            }
    }
};
struct EpiResid {
    static constexpr bool PERM = false, AFTER_DRAIN = false;
    const float* res; float* out; const float* gmod; float gs;
    __device__ __forceinline__ void operator()(const pg8::f32x4 (&acc)[2][2][4][2], const pg8::Unit& u, int wr, int wc, int fr, int fq) const {
        const int row0 = u.pm * 256 + wr * 64 + fr, col0 = u.pn * 256 + wc * 32 + 4 * fq;
        const float* gp = gmod + (size_t)(u.pm >> 5) * 9216 + col0;
        pg8::f32x4 g[2][2];
#pragma unroll
        for (int bj = 0; bj < 2; ++bj)
#pragma unroll
            for (int n = 0; n < 2; ++n) g[bj][n] = *(const pg8::f32x4*)(gp + bj * 128 + n * 16) * gs;
#pragma unroll
        for (int ai = 0; ai < 2; ++ai)
#pragma unroll
            for (int m = 0; m < 4; ++m) {
                const size_t off = (size_t)(row0 + ai * 128 + m * 16) * DM + col0;
#pragma unroll
                for (int bj = 0; bj < 2; ++bj)
#pragma unroll
                    for (int n = 0; n < 2; ++n) {
                        const pg8::f32x4 rv = *(const pg8::f32x4*)(res + off + bj * 128 + n * 16);
                        *(pg8::f32x4*)(out + off + bj * 128 + n * 16) = rv + g[bj][n] * acc[ai][bj][m][n];
                    }
            }
    }
};
struct EpiWin {
    static constexpr bool PERM = true, AFTER_DRAIN = false;
    unsigned char* ws; const float* gate_bias;
    __device__ __forceinline__ void operator()(const pg8::f32x4 (&acc)[2][2][4][2], const pg8::Unit& u, int wr, int wc, int fr, int fq) const {
        const int pn = u.pn;
        const int row0 = u.pm * 256 + wr * 64 + fr, cc0 = wc * 32 + 8 * fq;
        if (pn == 5) {
            h16* KIDX = (h16*)(ws + WS_KIDX); float* WIDX = (float*)(ws + WS_WIDX); float* GI = (float*)(ws + WS_GI); float* GF = (float*)(ws + WS_GF);
#pragma unroll
            for (int ai = 0; ai < 2; ++ai)
#pragma unroll
                for (int m = 0; m < 4; ++m) {
                    const int row = row0 + ai * 128 + m * 16;
                    if (cc0 < 64) {
                        float r[8];
#pragma unroll
                        for (int n = 0; n < 2; ++n)
#pragma unroll
                            for (int i = 0; i < 4; ++i) r[n * 4 + i] = acc[ai][0][m][n][i];
                        *(half8*)(KIDX + (size_t)row * 64 + cc0) = pack8(r);
                    } else if (cc0 == 64) {
#pragma unroll
                        for (int n = 0; n < 2; ++n) *(pg8::f32x4*)(WIDX + (size_t)row * 8 + n * 4) = acc[ai][0][m][n] * IDX_SCALE;
                    } else if (cc0 == 72) {
                        pg8::f32x4 gi, gf;
#pragma unroll
                        for (int i = 0; i < 4; ++i) { gi[i] = acc[ai][0][m][0][i] + gate_bias[i]; gf[i] = logsigmoid_f(acc[ai][0][m][1][i] + gate_bias[4 + i]); }
                        *(pg8::f32x4*)(GI + (size_t)row * 4) = gi; *(pg8::f32x4*)(GF + (size_t)row * 4) = gf;
                    }
                }
            return;
        }
        size_t dst; int ld, cb; bool sg = false;
        if (pn < 2)       { dst = WS_QA;   ld = 512;  cb = pn * 256; }
        else if (pn == 2) { dst = WS_CKV;  ld = 256;  cb = 0; }
        else if (pn < 5)  { dst = WS_QIDX; ld = 512;  cb = (pn - 3) * 256; }
        else if (pn < 8)  { dst = WS_QM;   ld = 512;  cb = (pn - 6) * 256; }
        else if (pn < 10) { dst = WS_KM;   ld = 512;  cb = (pn - 8) * 256; }
        else if (pn < 12) { dst = WS_VM;   ld = 512;  cb = (pn - 10) * 256; }
        else if (pn < 14) { dst = WS_OG;   ld = 512;  cb = (pn - 12) * 256; sg = true; }
        else if (pn < 18) { dst = WS_GA;   ld = 1024; cb = (pn - 14) * 256; sg = true; }
        else              { dst = WS_GM;   ld = 1024; cb = (pn - 18) * 256; sg = true; }
        h16* O = (h16*)(ws + dst);
#pragma unroll
        for (int ai = 0; ai < 2; ++ai)
#pragma unroll
            for (int m = 0; m < 4; ++m) {
                h16* rowp = O + (size_t)(row0 + ai * 128 + m * 16) * ld + cb + cc0;
#pragma unroll
                for (int bj = 0; bj < 2; ++bj) {
                    float r[8];
#pragma unroll
                    for (int n = 0; n < 2; ++n)
#pragma unroll
                        for (int i = 0; i < 4; ++i) { const float v = acc[ai][bj][m][n][i]; r[n * 4 + i] = sg ? sigmoid_f(v) : v; }
                    *(half8*)(rowp + bj * 128) = pack8(r);
                }
            }
    }
};
template <bool ACCUM> struct EpiMerge {
    static constexpr bool PERM = true, AFTER_DRAIN = false;
    const h16* gate; h16* O;
    __device__ __forceinline__ void operator()(const pg8::f32x4 (&acc)[2][2][4][2], const pg8::Unit& u, int wr, int wc, int fr, int fq) const {
        const int row0 = u.pm * 256 + wr * 64 + fr, col0 = u.pn * 256 + wc * 32 + 8 * fq;
#pragma unroll
        for (int ai = 0; ai < 2; ++ai)
#pragma unroll
            for (int m = 0; m < 4; ++m) {
                const size_t off = (size_t)(row0 + ai * 128 + m * 16) * DM + col0;
#pragma unroll
                for (int bj = 0; bj < 2; ++bj) {
                    const half8 gv = *(const half8*)(gate + off + bj * 128);
                    half8 ov; if (ACCUM) ov = *(const half8*)(O + off + bj * 128);
                    float r[8];
#pragma unroll
                    for (int n = 0; n < 2; ++n)
#pragma unroll
                        for (int i = 0; i < 4; ++i) { float v = (float)gv[n * 4 + i] * acc[ai][bj][m][n][i]; if (ACCUM) v += (float)ov[n * 4 + i]; r[n * 4 + i] = v; }
                    *(half8*)(O + off + bj * 128) = pack8(r);
                }
            }
    }
};

template <int MAP> __device__ __forceinline__ int wmap(int j) {
    if (MAP == 0) return j;
    if (MAP == 1) return 256 * (j >> 7) + (j & 127);
    if (MAP == 2) return 256 * (j >> 7) + 128 + (j & 127);
    if (j < 1352) return j;
    if (j < 1864) return 1536 + (j - 1352);
    if (j < 2376) return 2048 + (j - 1864);
    if (j < 2888) return 2560 + (j - 2376);
    if (j < 2892) return 1352 + (j - 2888);
    if (j < 2896) return 1356 + (j - 2892);
    if (j < 3408) return 3072 + (j - 2896);
    if (j < 4432) return 3584 + (j - 3408);
    return 4608 + (j - 4432);
}
template <int MAP> __device__ __forceinline__ void transpose_item(const float* W, int K, int N, h16* WT, LAS float* scr, int item, int lane) {
    const int nblk = (N + 31) / 32, kb = item / nblk, nb = item % nblk, k0 = 64 * kb, n0 = 32 * nb;
    const int ncol = n0 + (lane & 31);
#pragma unroll 8
    for (int i = 0; i < 32; ++i) { const int kk = 2 * i + (lane >> 5); scr[kk * 33 + (lane & 31)] = (ncol < N) ? W[(size_t)(k0 + kk) * N + ncol] : 0.f; }
    asm volatile("s_waitcnt lgkmcnt(0)" ::: "memory");
    const int c = lane & 7;
#pragma unroll
    for (int j = 0; j < 4; ++j) {
        const int n = (lane >> 3) + 8 * j; const LAS float* s = scr + (8 * c) * 33 + n;
        float v[8];
#pragma unroll
        for (int q = 0; q < 8; ++q) v[q] = s[q * 33];
        if (n0 + n < N) *(half8*)(WT + (size_t)wmap<MAP>(n0 + n) * K + k0 + 8 * c) = pack8(v);
    }
    asm volatile("s_waitcnt lgkmcnt(0)" ::: "memory");
}
template <int MAP> __device__ __forceinline__ void transpose_mat(const float* W, int K, int N, h16* WT, LAS float* scr, int gw, int ngw, int lane) {
    const int nitems = (K / 64) * ((N + 31) / 32);
    for (int it = gw; it < nitems; it += ngw) transpose_item<MAP>(W, K, N, WT, scr, it, lane);
}

__device__ __forceinline__ void phase_prologue(const Args& a, LAS unsigned char* lds, int vcu, int G) {
    const int tid = threadIdx.x, lane = tid & 63, wave = __builtin_amdgcn_readfirstlane(tid >> 6);
    unsigned char* ws = a.ws;
    LAS float* scr = (LAS float*)(lds + wave * 16384);
    const int gw = vcu * NWAVES + wave, ngw = G * NWAVES;
    transpose_mat<1>(a.in[5], DM, DFF, (h16*)(ws + WS_W13A), scr, gw, ngw, lane);
    transpose_mat<2>(a.in[6], DM, DFF, (h16*)(ws + WS_W13A), scr, gw, ngw, lane);
    transpose_mat<0>(a.in[7], DFF, DM, (h16*)(ws + WS_W2A), scr, gw, ngw, lane);
    transpose_mat<3>(a.in[9], DM, DIN, (h16*)(ws + WS_WIN), scr, gw, ngw, lane);
    transpose_mat<0>(a.in[18], 512, DM, (h16*)(ws + WS_WBA), scr, gw, ngw, lane);
    transpose_mat<0>(a.in[19], 512, DM, (h16*)(ws + WS_WBM), scr, gw, ngw, lane);
    transpose_mat<0>(a.in[20], DM, DM, (h16*)(ws + WS_WOUT), scr, gw, ngw, lane);
    {
        const float* wuk = a.in[13]; const float* wuv = a.in[14]; h16* ouk = (h16*)(ws + WS_WUK); h16* ouvt = (h16*)(ws + WS_WUVT);
        for (int i = vcu * NTHR + tid; i < 8 * 256 * 64; i += G * NTHR) {
            ouk[i] = (h16)wuk[i];
            const int h = i >> 14, d = (i >> 8) & 63, c = i & 255;
            ouvt[i] = (h16)wuv[(h * 256 + c) * 64 + d];
        }
    }
    {
        const float* cin = a.in[1]; const float* aw = a.in[2]; float* modp = (float*)(ws + WS_MODP);
        for (int it = vcu; it < NKS * 18; it += G) {
            const int ks = it / 18, cb = it % 18, j = cb * 512 + tid;
            float a0 = 0.f, a1 = 0.f;
#pragma unroll 8
            for (int k = ks * 64; k < ks * 64 + 64; ++k) {
                const float w = aw[(size_t)k * 9216 + j];
                a0 += silu_f(cin[k]) * w; a1 += silu_f(cin[DM + k]) * w;
            }
            modp[(size_t)(ks * 2 + 0) * 9216 + j] = a0; modp[(size_t)(ks * 2 + 1) * 9216 + j] = a1;
        }
    }
}

__device__ __forceinline__ void convert_ffn2_weights(const Args& a, LAS unsigned char* lds, int vcu, int G) {
    const int tid = threadIdx.x, lane = tid & 63, wave = __builtin_amdgcn_readfirstlane(tid >> 6);
    LAS float* scr = (LAS float*)(lds + 32768 + wave * 16384);
    const int gw = vcu * NWAVES + wave, ngw = G * NWAVES;
    transpose_mat<1>(a.in[22], DM, DFF, (h16*)(a.ws + WS_W13B), scr, gw, ngw, lane);
    transpose_mat<2>(a.in[23], DM, DFF, (h16*)(a.ws + WS_W13B), scr, gw, ngw, lane);
    transpose_mat<0>(a.in[24], DFF, DM, (h16*)(a.ws + WS_W2B), scr, gw, ngw, lane);
}

template <int MODE> __device__ __forceinline__ void phase_norm(const Args& a, LAS unsigned char* lds, int vcu, int G, const float* xin, const float* gain, int chunk_sh, h16* xn_out, float* f32_out) {
    const int tid = threadIdx.x, lane = tid & 63, wave = __builtin_amdgcn_readfirstlane(tid >> 6);
    LAS float* modL = (LAS float*)lds;
    const float* modp = (const float*)(a.ws + WS_MODP); float* mod = (float*)(a.ws + WS_MOD); const float* adab = a.in[3];
    if (MODE == 0) {
        for (int i = tid; i < 4096; i += NTHR) {
            const int b = i >> 11, which = (i >> 10) & 1, col = i & 1023, j = (chunk_sh + which) * 1024 + col;
            float s = adab[j];
            for (int ks = 0; ks < NKS; ++ks) s += modp[(size_t)(ks * 2 + b) * 9216 + j];
            modL[i] = which ? 1.f + s : s;
        }
        for (int i = vcu * NTHR + tid; i < 2 * 9216; i += G * NTHR) {
            const int b = i / 9216, j = i % 9216;
            float s = adab[j];
            for (int ks = 0; ks < NKS; ++ks) s += modp[(size_t)(ks * 2 + b) * 9216 + j];
            mod[i] = s;
        }
        __syncthreads();
    } else if (MODE == 1) {
        for (int i = tid; i < 4096; i += NTHR) {
            const int b = i >> 11, which = (i >> 10) & 1, col = i & 1023;
            const float s = mod[(size_t)b * 9216 + (chunk_sh + which) * 1024 + col];
            modL[i] = which ? 1.f + s : s;
        }
        __syncthreads();
    }
    const int gw = vcu * NWAVES + wave, ngw = G * NWAVES;
    for (int m = gw; m < MTOK; m += ngw) {
        const pg8::f32x4* xr = (const pg8::f32x4*)(xin + (size_t)m * DM) + lane;
        pg8::f32x4 v[4]; float s = 0.f;
#pragma unroll
        for (int j = 0; j < 4; ++j) { v[j] = xr[64 * j]; s += (v[j].x * v[j].x + v[j].y * v[j].y) + (v[j].z * v[j].z + v[j].w * v[j].w); }
        WAVE_SUM(s);
        const float rstd = 1.0f / sqrtf(s * (1.f / DM) + EPS);
        const int b = m / SEQ;
#pragma unroll
        for (int j = 0; j < 4; ++j) {
            const int col = 4 * lane + 256 * j;
            const pg8::f32x4 g = *(const pg8::f32x4*)(gain + col);
            pg8::f32x4 y = v[j] * rstd * g;
            if (MODE == 2) { *((pg8::f32x4*)(f32_out + (size_t)m * DM) + lane + 64 * j) = y; }
            else {
                const pg8::f32x4 sh = *(const LAS pg8::f32x4*)(modL + (b * 2 + 0) * 1024 + col), sc = *(const LAS pg8::f32x4*)(modL + (b * 2 + 1) * 1024 + col);
                y = y * sc + sh;
                half4 o; o[0] = (h16)y.x; o[1] = (h16)y.y; o[2] = (h16)y.z; o[3] = (h16)y.w;
                *(half4*)(xn_out + (size_t)m * DM + col) = o;
            }
        }
    }
}

__device__ __forceinline__ void kv_finalize(const Args& a, int vcu, int G) {
    const int tid = threadIdx.x, lane = tid & 63, wave = __builtin_amdgcn_readfirstlane(tid >> 6);
    h16* ckv = (h16*)(a.ws + WS_CKV); const float* g = a.in[12];
    const int gw = vcu * NWAVES + wave, ngw = G * NWAVES;
    const pg8::f32x4 gv = *(const pg8::f32x4*)(g + 4 * lane);
    for (int m = gw; m < MTOK; m += ngw) {
        half4 v = *(half4*)(ckv + (size_t)m * 256 + 4 * lane);
        float f0 = (float)v[0], f1 = (float)v[1], f2 = (float)v[2], f3 = (float)v[3];
        float s = (f0 * f0 + f1 * f1) + (f2 * f2 + f3 * f3);
        WAVE_SUM(s);
        const float rstd = 1.0f / sqrtf(s * (1.f / 256.f) + EPS);
        half4 o; o[0] = (h16)(f0 * rstd * gv.x); o[1] = (h16)(f1 * rstd * gv.y); o[2] = (h16)(f2 * rstd * gv.z); o[3] = (h16)(f3 * rstd * gv.w);
        *(half4*)(ckv + (size_t)m * 256 + 4 * lane) = o;
    }
}

__device__ __forceinline__ unsigned f2key(float f) { const unsigned u = __float_as_uint(f); return (u & 0x80000000u) ? ~u : (u | 0x80000000u); }
__device__ __forceinline__ float key2f(unsigned k) { const unsigned u = (k & 0x80000000u) ? (k & 0x7fffffffu) : ~k; return __uint_as_float(u); }
constexpr int CAP = 512;
__device__ __forceinline__ unsigned select256(LAS float* scB, LAS unsigned short* ixB, int n, int lane) {
    unsigned key[8]; unsigned short idv[8]; float scv[8];
#pragma unroll
    for (int j = 0; j < 8; ++j) { const int i = lane + 64 * j; const bool ok = i < n; scv[j] = ok ? scB[i] : 0.f; idv[j] = ok ? ixB[i] : (unsigned short)0; key[j] = ok ? f2key(scv[j]) : 0u; }
    unsigned T = 0u;
    for (int bit = 31; bit >= 0; --bit) {
        const unsigned cand = T | (1u << bit); int c = 0;
#pragma unroll
        for (int j = 0; j < 8; ++j) c += __popcll(__ballot(key[j] >= cand));
        if (c >= TOPK) T = cand;
    }
    int ngt = 0;
#pragma unroll
    for (int j = 0; j < 8; ++j) ngt += __popcll(__ballot(key[j] > T));
    const int need_eq = TOPK - ngt;
    const unsigned long long lt = (1ull << lane) - 1ull;
    int base = 0, eqbase = 0;
#pragma unroll
    for (int j = 0; j < 8; ++j) {
        const bool gt = key[j] > T, eq = key[j] == T;
        const unsigned long long meq = __ballot(eq);
        const int eqrank = eqbase + __popcll(meq & lt);
        const bool keep = gt || (eq && eqrank < need_eq);
        const unsigned long long mk = __ballot(keep);
        const int pos = base + __popcll(mk & lt);
        if (keep) { scB[pos] = scv[j]; ixB[pos] = idv[j]; }
        base += __popcll(mk); eqbase += __popcll(meq);
    }
    return T;
}

__device__ __forceinline__ float prune_approx(LAS float* scB, LAS unsigned short* ixB, int n, float thr_old, int lane, int* newcnt) {
    float scv[8]; unsigned short idv[8];
#pragma unroll
    for (int j = 0; j < 8; ++j) { const int i = lane + 64 * j; const bool ok = i < n; scv[j] = ok ? scB[i] : -INFINITY; idv[j] = ok ? ixB[i] : (unsigned short)0; }
    float mx = scv[0], mn = (lane < n) ? scv[0] : INFINITY;
#pragma unroll
    for (int j = 1; j < 8; ++j) { mx = fmaxf(mx, scv[j]); mn = fminf(mn, (lane + 64 * j < n) ? scv[j] : INFINITY); }
    WAVE_MAX(mx);
#pragma unroll
    for (int o = 1; o < 64; o <<= 1) mn = fminf(mn, __shfl_xor(mn, o));
    float lo = fmaxf(thr_old, mn), hi = mx; int clo = n;
    for (int it = 0; it < 12; ++it) {
        const float mid = 0.5f * lo + 0.5f * hi;
        if (!(mid > lo) || !(mid < hi)) break;
        int c = 0;
#pragma unroll
        for (int j = 0; j < 8; ++j) c += __popcll(__ballot(scv[j] >= mid));
        if (c >= TOPK) { lo = mid; clo = c; if (c <= TOPK + 48) break; } else hi = mid;
    }
    const unsigned long long lt = (1ull << lane) - 1ull;
    int base = 0;
#pragma unroll
    for (int j = 0; j < 8; ++j) {
        const bool keep = scv[j] >= lo;
        const unsigned long long mk = __ballot(keep);
        const int pos = base + __popcll(mk & lt);
        if (keep) { scB[pos] = scv[j]; ixB[pos] = idv[j]; }
        base += __popcll(mk);
    }
    *newcnt = clo;
    return lo;
}

__device__ __forceinline__ void indexer_unit(const Args& a, LAS unsigned char* lds, int b, int blk) {
    const int tid = threadIdx.x, lane = tid & 63, wave = __builtin_amdgcn_readfirstlane(tid >> 6);
    const h16* QIDX = (const h16*)(a.ws + WS_QIDX); const h16* KIDX = (const h16*)(a.ws + WS_KIDX); const float* WIDX = (const float*)(a.ws + WS_WIDX);
    unsigned short* SEL = (unsigned short*)(a.ws + WS_SEL);
    const int t0 = blk * 32; const size_t rowb = (size_t)b * SEQ;
    LAS unsigned char* st = lds;
    LAS float* scW = (LAS float*)(lds + 18432 + wave * 12288);
    LAS unsigned short* ixW = (LAS unsigned short*)(lds + 18432 + wave * 12288 + 8192);
    const int fr = lane & 15, fq = lane >> 4, tw = t0 + 4 * wave, t = tw + fq;
    half8 qa[2][2];
#pragma unroll
    for (int g = 0; g < 2; ++g)
#pragma unroll
        for (int ks = 0; ks < 2; ++ks) qa[g][ks] = *(const half8*)(QIDX + (rowb + tw + (fr >> 2)) * 512 + ((fr & 3) + 4 * g) * 64 + ks * 32 + fq * 8);
    const pg8::f32x4 w0 = *(const pg8::f32x4*)(WIDX + (rowb + t) * 8), w1 = *(const pg8::f32x4*)(WIDX + (rowb + t) * 8 + 4);
    float thr = -INFINITY; int cnt = 0;
    const int nst = t0 / 64 + 1;
    const h16* ksrc = KIDX + (rowb + (tid >> 3)) * 64 + (tid & 7) * 8;
    u32x4 pre = *(const u32x4*)ksrc;
    for (int si = 0; si < nst; ++si) {
        LAS unsigned char* sb = st + (si & 1) * 9216;
        *(LAS u32x4*)(sb + (tid >> 3) * 144 + (tid & 7) * 16) = pre;
        __syncthreads();
        if (si + 1 < nst) pre = *(const u32x4*)(ksrc + (size_t)(si + 1) * 64 * 64);
        const int s0 = si * 64;
#pragma unroll
        for (int kb = 0; kb < 4; ++kb) {
            const int sblk = s0 + 16 * kb;
            if (sblk <= tw + 3) {
                const half8 k0 = *(const LAS half8*)(sb + (16 * kb + fr) * 144 + fq * 16), k1 = *(const LAS half8*)(sb + (16 * kb + fr) * 144 + 64 + fq * 16);
                pg8::f32x4 a0 = {0.f, 0.f, 0.f, 0.f}, a1 = {0.f, 0.f, 0.f, 0.f};
                a0 = mfma16(qa[0][0], k0, a0); a0 = mfma16(qa[0][1], k1, a0);
                a1 = mfma16(qa[1][0], k0, a1); a1 = mfma16(qa[1][1], k1, a1);
                float sc = 0.f;
                sc = fmaf(w0.x, fmaxf(a0[0], 0.f), sc); sc = fmaf(w0.y, fmaxf(a0[1], 0.f), sc); sc = fmaf(w0.z, fmaxf(a0[2], 0.f), sc); sc = fmaf(w0.w, fmaxf(a0[3], 0.f), sc);
                sc = fmaf(w1.x, fmaxf(a1[0], 0.f), sc); sc = fmaf(w1.y, fmaxf(a1[1], 0.f), sc); sc = fmaf(w1.z, fmaxf(a1[2], 0.f), sc); sc = fmaf(w1.w, fmaxf(a1[3], 0.f), sc);
                const int s = sblk + fr;
                const bool pass = (s <= t) && (sc >= thr);
                const unsigned long long mask = __ballot(pass);
                const unsigned fld = (unsigned)(mask >> (16 * fq)) & 0xffffu;
                const int prefix = __popc(fld & ((1u << fr) - 1u));
                if (pass) { const int p = cnt + prefix; scW[fq * CAP + p] = sc; ixW[fq * CAP + p] = (unsigned short)s; }
                cnt += __popc(fld);
            }
        }
#pragma unroll
        for (int tk = 0; tk < 4; ++tk) {
            const int c = __builtin_amdgcn_readlane(cnt, 16 * tk);
            if (c > CAP - 64) {
                int nc; const float thr_old = __builtin_bit_cast(float, __builtin_amdgcn_readlane(__builtin_bit_cast(int, thr), 16 * tk));
                const float nthr = prune_approx(scW + tk * CAP, ixW + tk * CAP, c, thr_old, lane, &nc);
                if (fq == tk) { thr = nthr; cnt = nc; }
            }
        }
    }
#pragma unroll
    for (int tk = 0; tk < 4; ++tk) {
        int c = __builtin_amdgcn_readlane(cnt, 16 * tk);
        if (c > TOPK) { (void)select256(scW + tk * CAP, ixW + tk * CAP, c, lane); c = TOPK; }
#pragma unroll
        for (int i = 0; i < 4; ++i) { const int k = lane + 64 * i; SEL[(rowb + tw + tk) * 256 + k] = (k < c) ? ixW[tk * CAP + k] : (unsigned short)0xFFFF; }
    }
    __syncthreads();
}
__device__ __forceinline__ void phase_indexer(const Args& a, LAS unsigned char* lds, int vcu, int G) {
    for (int p = vcu; p < 256; p += G) { indexer_unit(a, lds, 0, p); indexer_unit(a, lds, 1, 255 - p); }
}

constexpr int SA_QABS = 0, SA_CH = 67584, SA_SELW = SA_CH + 8 * 8704, SA_BIAS = SA_SELW + 8192, SA_END = SA_BIAS + 1024;
static_assert(SA_END <= MISC_OFF, "sparse attention LDS");
typedef short v4i16_t __attribute__((ext_vector_type(4)));
typedef int i32x4 __attribute__((ext_vector_type(4)));
__device__ __forceinline__ half4 tr_read4(const LAS h16* p) { return __builtin_bit_cast(half4, __builtin_amdgcn_ds_read_tr16_b64_v4i16((LAS v4i16_t*)p)); }
__device__ __forceinline__ float xl_max(float v) {
    auto r = __builtin_amdgcn_permlane16_swap(__float_as_uint(v), __float_as_uint(v), false, false);
    v = fmaxf(__uint_as_float(r[0]), __uint_as_float(r[1]));
    auto q = __builtin_amdgcn_permlane32_swap(__float_as_uint(v), __float_as_uint(v), false, false);
    return fmaxf(__uint_as_float(q[0]), __uint_as_float(q[1]));
}
__device__ __forceinline__ float xl_sum(float v) {
    auto r = __builtin_amdgcn_permlane16_swap(__float_as_uint(v), __float_as_uint(v), false, false);
    v = __uint_as_float(r[0]) + __uint_as_float(r[1]);
    auto q = __builtin_amdgcn_permlane32_swap(__float_as_uint(v), __float_as_uint(v), false, false);
    return __uint_as_float(q[0]) + __uint_as_float(q[1]);
}
__device__ __forceinline__ int t5_bucket(int dist) {
    const int n = dist < 0 ? 0 : dist;
    const int lg = 16 + (int)(__log2f((float)(n < 1 ? 1 : n) * 0.0625f) * 5.333333333f);
    return n < 16 ? n : (lg > 31 ? 31 : lg);
}
struct SaState { float m, l; pg8::f32x4 O[16]; };
__device__ __forceinline__ void sattn_chunk(SaState& st, const half8 (&ac)[8], const half8 (&qb)[8], half8 bfrag, int krow_pos, int t, int ch, int nvalid, LAS h16* CH, int fr, int fq) {
    {
        const int lane_ = fq * 16 + fr, rsel = lane_ >> 5, piece = lane_ & 31;
#pragma unroll
        for (int i = 0; i < 8; ++i) *(LAS half8*)(CH + (2 * i + rsel) * 272 + piece * 8) = ac[i];
    }
    pg8::f32x4 S = {0.f, 0.f, 0.f, 0.f};
    {
        const int j = t5_bucket(t - krow_pos) - 8 * fq;
        const unsigned one = 0x3C00u << ((j & 1) * 16);
        u32x4 oh; oh[0] = ((j >> 1) == 0) ? one : 0u; oh[1] = ((j >> 1) == 1) ? one : 0u; oh[2] = ((j >> 1) == 2) ? one : 0u; oh[3] = ((j >> 1) == 3) ? one : 0u;
        S = mfma16(__builtin_bit_cast(half8, oh), bfrag, S);
    }
#pragma unroll
    for (int cs = 0; cs < 8; ++cs) S = mfma16(*(const LAS half8*)(CH + fr * 272 + cs * 32 + fq * 8), qb[cs], S);
    half4 at[8];
#pragma unroll
    for (int cb = 0; cb < 8; ++cb) at[cb] = tr_read4(CH + (4 * fq + (fr >> 2)) * 272 + cb * 16 + 4 * (fr & 3));
    float sv[4];
#pragma unroll
    for (int r = 0; r < 4; ++r) sv[r] = (ch * 16 + 4 * fq + r < nvalid) ? S[r] : -INFINITY;
    const float cmax = xl_max(fmaxf(fmaxf(sv[0], sv[1]), fmaxf(sv[2], sv[3])));
    const float mn = fmaxf(st.m, cmax);
    if (__any(mn > st.m)) {
        const float sc = __expf(st.m - mn);
        st.l *= sc;
#pragma unroll
        for (int cb = 0; cb < 16; ++cb) st.O[cb] *= sc;
    }
    st.m = mn;
    half4 pf; float ps = 0.f;
#pragma unroll
    for (int r = 0; r < 4; ++r) { const float p = __expf(sv[r] - mn); ps += p; pf[r] = (h16)p; }
    st.l += ps;
#pragma unroll
    for (int cb = 0; cb < 8; ++cb) st.O[cb] = __builtin_amdgcn_mfma_f32_16x16x16f16(at[cb], pf, st.O[cb], 0, 0, 0);
#pragma unroll
    for (int cb = 0; cb < 8; ++cb) at[cb] = tr_read4(CH + (4 * fq + (fr >> 2)) * 272 + (cb + 8) * 16 + 4 * (fr & 3));
#pragma unroll
    for (int cb = 0; cb < 8; ++cb) st.O[cb + 8] = __builtin_amdgcn_mfma_f32_16x16x16f16(at[cb], pf, st.O[cb + 8], 0, 0, 0);
}
__device__ __forceinline__ void sattn_unit(const Args& a, LAS unsigned char* lds, int unit) {
    const int tid = threadIdx.x, lane = tid & 63, wave = __builtin_amdgcn_readfirstlane(tid >> 6);
    const int fr = lane & 15, fq = lane >> 4;
    const h16* QA = (const h16*)(a.ws + WS_QA); const h16* CKV = (const h16*)(a.ws + WS_CKV); const h16* WUK = (const h16*)(a.ws + WS_WUK); const h16* WUVT = (const h16*)(a.ws + WS_WUVT);
    const unsigned short* SEL = (const unsigned short*)(a.ws + WS_SEL); h16* YA = (h16*)(a.ws + WS_YA);
    LAS h16* QABS = (LAS h16*)(lds + SA_QABS); LAS h16* CH = (LAS h16*)(lds + SA_CH + wave * 8704); LAS int* SELW = (LAS int*)(lds + SA_SELW) + wave * 256;
    LAS float* BIAS = (LAS float*)(lds + SA_BIAS);
    const int row0 = unit * 16, b = row0 / SEQ, tpos0 = row0 - b * SEQ;
    const size_t rowb = (size_t)b * SEQ;
    half8 bfrag;
#pragma unroll
    for (int j = 0; j < 8; ++j) bfrag[j] = (h16)BIAS[(8 * fq + j) * 8 + (fr & 7)];
    {
        const int h = wave;
        half8 af[2];
#pragma unroll
        for (int ks = 0; ks < 2; ++ks) af[ks] = *(const half8*)(QA + (size_t)(row0 + fr) * 512 + h * 64 + ks * 32 + fq * 8);
#pragma unroll 8
        for (int cb = 0; cb < 16; ++cb) {
            pg8::f32x4 acc = {0.f, 0.f, 0.f, 0.f};
#pragma unroll
            for (int ks = 0; ks < 2; ++ks) acc = mfma16(af[ks], *(const half8*)(WUK + (size_t)(h * 256 + cb * 16 + fr) * 64 + ks * 32 + fq * 8), acc);
#pragma unroll
            for (int r = 0; r < 4; ++r) QABS[((4 * fq + r) * 8 + h) * 264 + cb * 16 + fr] = (h16)(acc[r] * 0.125f);
        }
    }
    __syncthreads();
#pragma unroll 1
    for (int tt = 0; tt < 2; ++tt) {
        const int tl = 2 * wave + tt, t = tpos0 + tl, row = row0 + tl;
#pragma unroll
        for (int i = 0; i < 4; ++i) SELW[lane + 64 * i] = (int)SEL[(size_t)row * 256 + lane + 64 * i];
        const int nvalid = (t + 1 < TOPK) ? t + 1 : TOPK;
        half8 qb[8];
#pragma unroll
        for (int cs = 0; cs < 8; ++cs) qb[cs] = *(const LAS half8*)(QABS + (tl * 8 + (fr & 7)) * 264 + cs * 32 + fq * 8);
        SaState st; st.m = -INFINITY; st.l = 0.f;
#pragma unroll
        for (int cb = 0; cb < 16; ++cb) st.O[cb] = (pg8::f32x4){0.f, 0.f, 0.f, 0.f};
        half8 fa[8], fb[8];
        int kpa, kpb;
#define SA_LOAD(dst, kp, ch) do { const int k_ = SELW[(ch) * 16 + fr]; kp = (k_ != 0xFFFF) ? k_ : 0; \
            _Pragma("unroll") for (int i_ = 0; i_ < 8; ++i_) { int r_ = SELW[(ch) * 16 + 2 * i_ + (lane >> 5)]; r_ = (r_ != 0xFFFF) ? r_ : 0; dst[i_] = *(const half8*)(CKV + (rowb + r_) * 256 + (lane & 31) * 8); } } while (0)
        SA_LOAD(fa, kpa, 0);
#pragma unroll 1
        for (int ch = 0; ch < 16; ch += 2) {
            SA_LOAD(fb, kpb, ch + 1);
            sattn_chunk(st, fa, qb, bfrag, kpa, t, ch, nvalid, CH, fr, fq);
            if (ch + 2 < 16) SA_LOAD(fa, kpa, ch + 2);
            sattn_chunk(st, fb, qb, bfrag, kpb, t, ch + 1, nvalid, CH, fr, fq);
        }
#undef SA_LOAD
        const float inv = 1.f / xl_sum(st.l);
        if (fr < 8) {
#pragma unroll
            for (int cb = 0; cb < 16; ++cb) {
                half4 ov; ov[0] = (h16)(st.O[cb][0] * inv); ov[1] = (h16)(st.O[cb][1] * inv); ov[2] = (h16)(st.O[cb][2] * inv); ov[3] = (h16)(st.O[cb][3] * inv);
                *(LAS half4*)(QABS + (tl * 8 + fr) * 264 + cb * 16 + 4 * fq) = ov;
            }
        }
    }
    __syncthreads();
    {
        const int h = wave;
#pragma unroll
        for (int db = 0; db < 4; ++db) {
            pg8::f32x4 acc = {0.f, 0.f, 0.f, 0.f};
#pragma unroll
            for (int cs = 0; cs < 8; ++cs) acc = mfma16(*(const LAS half8*)(QABS + (fr * 8 + h) * 264 + cs * 32 + fq * 8), *(const half8*)(WUVT + (size_t)(h * 64 + db * 16 + fr) * 256 + cs * 32 + fq * 8), acc);
#pragma unroll
            for (int r = 0; r < 4; ++r) YA[(size_t)(row0 + 4 * fq + r) * 512 + h * 64 + db * 16 + fr] = (h16)acc[r];
        }
    }
    __syncthreads();
}
__device__ __forceinline__ void phase_sattn(const Args& a, LAS unsigned char* lds, int vcu, int G) {
    const int tid = threadIdx.x;
    LAS float* BIAS = (LAS float*)(lds + SA_BIAS);
    if (tid < 256) BIAS[tid] = a.in[17][tid];
    __syncthreads();
    if (G == 256) {
        const int j = vcu >> 5, w = vcu & 31;
        for (int i = 0; i < 4; ++i) sattn_unit(a, lds, (j >> 2) * 512 + (j & 3) * 128 + i * 32 + w);
    } else {
        for (int u = vcu; u < MTOK / 16; u += G) sattn_unit(a, lds, u);
    }
}

__device__ __forceinline__ void mlstmA_unit(const Args& a, LAS unsigned char* lds, int u) {
    const int tid = threadIdx.x, lane = tid & 63, wave = __builtin_amdgcn_readfirstlane(tid >> 6);
    const int fr = lane & 15, fq = lane >> 4;
    const int bh = u >> 7, j = u & 127, b = bh >> 2, h = bh & 3, tpos0 = j * 64; const size_t rowb = (size_t)b * SEQ, r0 = rowb + tpos0;
    const h16* QM = (const h16*)(a.ws + WS_QM); const h16* KM = (const h16*)(a.ws + WS_KM); const h16* VM = (const h16*)(a.ws + WS_VM);
    const float* GI = (const float*)(a.ws + WS_GI); const float* GF = (const float*)(a.ws + WS_GF);
    h16* Q2 = (h16*)(a.ws + WS_Q2); h16* K2 = (h16*)(a.ws + WS_K2); h16* UT = (h16*)(a.ws + WS_UT);
    float* NVEC = (float*)(a.ws + WS_NVEC); float* MLOC = (float*)(a.ws + WS_MLOC); float* BLAST = (float*)(a.ws + WS_BLAST);
    const float* convw = a.in[10]; const float* convb = a.in[11];
    LAS h16* KWT = (LAS h16*)lds; LAS h16* VT = (LAS h16*)(lds + 18432); LAS float* wL = (LAS float*)(lds + 36864);
    if (tid < 64) {
        const int s = tid;
        const float lf = GF[(r0 + s) * 4 + h], ig = GI[(r0 + s) * 4 + h];
        float bs = lf;
#pragma unroll
        for (int off = 1; off < 64; off <<= 1) { const float v = __shfl_up(bs, off); if (lane >= off) bs += v; }
        const float bl = __shfl(bs, 63);
        const float g = bl - bs + ig;
        float ml = g; WAVE_MAX(ml);
        wL[s] = __expf(g - ml);
        if (tid == 0) { MLOC[u] = ml; BLAST[u] = bl; }
    }
    __syncthreads();
#pragma unroll 1
    for (int it = 0; it < 2; ++it) {
        const int p = tid + NTHR * it, s = p >> 4, cg = p & 15, colh = h * 128 + cg * 8;
#pragma unroll
        for (int tz = 0; tz < 2; ++tz) {
            const h16* src = tz ? KM : QM; const int ccol = tz * 512 + colh;
            float acc[8];
#pragma unroll
            for (int i = 0; i < 8; ++i) acc[i] = convb[ccol + i];
#pragma unroll
            for (int w = 0; w < 4; ++w) {
                const int tp = tpos0 + s - 3 + w;
                if (tp >= 0) {
                    const half8 x = *(const half8*)(src + (rowb + tp) * 512 + colh);
#pragma unroll
                    for (int i = 0; i < 8; ++i) acc[i] += convw[w * 1024 + ccol + i] * (float)x[i];
                }
            }
            if (tz == 0) {
#pragma unroll
                for (int i = 0; i < 8; ++i) acc[i] = silu_f(acc[i]);
                *(half8*)(Q2 + (r0 + s) * 512 + colh) = pack8(acc);
            } else {
                const float ws_ = wL[s];
#pragma unroll
                for (int i = 0; i < 8; ++i) acc[i] = silu_f(acc[i]) * 0.08838834764831845f;
                *(half8*)(K2 + (r0 + s) * 512 + colh) = pack8(acc);
#pragma unroll
                for (int i = 0; i < 8; ++i) KWT[(cg * 8 + i) * 72 + s] = (h16)(acc[i] * ws_);
            }
        }
        const half8 v = *(const half8*)(VM + (r0 + s) * 512 + colh);
#pragma unroll
        for (int i = 0; i < 8; ++i) VT[(cg * 8 + i) * 72 + s] = v[i];
    }
    __syncthreads();
    if (tid < 128) {
        float sum = 0.f;
        for (int s = 0; s < 64; ++s) sum += (float)KWT[tid * 72 + s];
        NVEC[(size_t)u * 128 + tid] = sum;
    }
#pragma unroll 2
    for (int db = 0; db < 8; ++db) {
        pg8::f32x4 acc = {0.f, 0.f, 0.f, 0.f};
#pragma unroll
        for (int ks = 0; ks < 2; ++ks) acc = mfma16(*(const LAS half8*)(VT + (wave * 16 + fr) * 72 + ks * 32 + fq * 8), *(const LAS half8*)(KWT + (db * 16 + fr) * 72 + ks * 32 + fq * 8), acc);
#pragma unroll
        for (int r = 0; r < 4; ++r) UT[(size_t)u * 16384 + (wave * 16 + 4 * fq + r) * 128 + db * 16 + fr] = (h16)acc[r];
    }
    __syncthreads();
}

__device__ __forceinline__ void phase_mlstmB(const Args& a, LAS unsigned char* lds, int vcu, int G) {
    const int tid = threadIdx.x;
    const float* MLOC = (const float*)(a.ws + WS_MLOC); const float* BLAST = (const float*)(a.ws + WS_BLAST); const float* NVEC = (const float*)(a.ws + WS_NVEC);
    const h16* UT = (const h16*)(a.ws + WS_UT); h16* CT = (h16*)(a.ws + WS_CT); float* NST = (float*)(a.ws + WS_NST); float* MST = (float*)(a.ws + WS_MST);
    LAS float* decL = (LAS float*)lds; LAS float* sclL = decL + 1024; LAS float* mL = sclL + 1024; LAS float* blL = mL + 1024; LAS float* mlL = blL + 1024;
    for (int i = tid; i < 1024; i += NTHR) { blL[i] = BLAST[i]; mlL[i] = MLOC[i]; }
    __syncthreads();
    if (tid < 8) {
        float m = 0.f;
        for (int j = 0; j < 128; ++j) {
            const float bl = blL[tid * 128 + j], ml = mlL[tid * 128 + j];
            mL[tid * 128 + j] = m;
            const float mn = fmaxf(bl + m, ml);
            decL[tid * 128 + j] = __expf(bl + m - mn); sclL[tid * 128 + j] = __expf(ml - mn); m = mn;
        }
    }
    __syncthreads();
    for (int idx = vcu * NTHR + tid; idx < 8 * 16384; idx += G * NTHR) {
        const int bh = idx >> 14, el = idx & 16383;
        float C = 0.f;
#pragma unroll 8
        for (int j = 0; j < 128; ++j) {
            const size_t off = (size_t)(bh * 128 + j) * 16384 + el;
            CT[off] = (h16)C;
            C = decL[bh * 128 + j] * C + sclL[bh * 128 + j] * (float)UT[off];
        }
    }
    for (int idx = vcu * NTHR + tid; idx < 8 * 128; idx += G * NTHR) {
        const int bh = idx >> 7, d = idx & 127;
        float n = 0.f;
        for (int j = 0; j < 128; ++j) {
            NST[(size_t)(bh * 128 + j) * 128 + d] = n;
            n = decL[bh * 128 + j] * n + sclL[bh * 128 + j] * NVEC[(size_t)(bh * 128 + j) * 128 + d];
            if (d == 0) MST[bh * 128 + j] = mL[bh * 128 + j];
        }
    }
}

constexpr int MC_QL = 0, MC_KL = 17408, MC_VT = 34816, MC_CTL = 53248, MC_PL = 88064, MC_HL = 97280, MC_SM = 131072;
__device__ __forceinline__ void mlstmC_unit(const Args& a, LAS unsigned char* lds, int u) {
    const int tid = threadIdx.x, lane = tid & 63, wave = __builtin_amdgcn_readfirstlane(tid >> 6);
    const int fr = lane & 15, fq = lane >> 4;
    const int bh = u >> 7, j_ = u & 127, b = bh >> 2, h = bh & 3; const size_t r0 = (size_t)b * SEQ + j_ * 64;
    const h16* Q2 = (const h16*)(a.ws + WS_Q2); const h16* K2 = (const h16*)(a.ws + WS_K2); const h16* VM = (const h16*)(a.ws + WS_VM); const h16* CT = (const h16*)(a.ws + WS_CT);
    const float* GI = (const float*)(a.ws + WS_GI); const float* GF = (const float*)(a.ws + WS_GF); const float* NST = (const float*)(a.ws + WS_NST); const float* MST = (const float*)(a.ws + WS_MST);
    const h16* OG = (const h16*)(a.ws + WS_OG); h16* HM = (h16*)(a.ws + WS_HM); const float* hnorm = a.in[16];
    LAS h16* QL = (LAS h16*)(lds + MC_QL); LAS h16* KL = (LAS h16*)(lds + MC_KL); LAS h16* VT = (LAS h16*)(lds + MC_VT); LAS h16* CTL = (LAS h16*)(lds + MC_CTL);
    LAS h16* PL = (LAS h16*)(lds + MC_PL); LAS float* HL = (LAS float*)(lds + MC_HL);
    LAS float* bL = (LAS float*)(lds + MC_SM); LAS float* aL = bL + 64; LAS float* mjL = bL + 128; LAS float* wiL = bL + 192; LAS float* denL = bL + 256; LAS float* nL = bL + 320;
#pragma unroll 1
    for (int it = 0; it < 2; ++it) {
        const int p = tid + NTHR * it, s = p >> 4, cg = p & 15, colh = h * 128 + cg * 8;
        *(LAS half8*)(QL + s * 136 + cg * 8) = *(const half8*)(Q2 + (r0 + s) * 512 + colh);
        *(LAS half8*)(KL + s * 136 + cg * 8) = *(const half8*)(K2 + (r0 + s) * 512 + colh);
        const half8 v = *(const half8*)(VM + (r0 + s) * 512 + colh);
#pragma unroll
        for (int i = 0; i < 8; ++i) VT[(cg * 8 + i) * 72 + s] = v[i];
    }
#pragma unroll 1
    for (int it = 0; it < 4; ++it) {
        const int p = tid + NTHR * it, e = p >> 4, cg = p & 15;
        *(LAS half8*)(CTL + e * 136 + cg * 8) = *(const half8*)(CT + (size_t)u * 16384 + e * 128 + cg * 8);
    }
    if (tid >= 64 && tid < 192) nL[tid - 64] = NST[(size_t)u * 128 + tid - 64];
    if (tid < 64) {
        const int s = tid;
        const float lf = GF[(r0 + s) * 4 + h], ig = GI[(r0 + s) * 4 + h];
        float bs = lf;
#pragma unroll
        for (int off = 1; off < 64; off <<= 1) { const float v = __shfl_up(bs, off); if (lane >= off) bs += v; }
        const float av = ig - bs;
        float cm = av;
#pragma unroll
        for (int off = 1; off < 64; off <<= 1) { const float v = __shfl_up(cm, off); if (lane >= off) cm = fmaxf(cm, v); }
        const float mp = MST[u];
        const float mj = bs + fmaxf(mp, cm);
        bL[s] = bs; aL[s] = av; mjL[s] = mj; wiL[s] = __expf(bs + mp - mj);
    }
    __syncthreads();
    {
        const int jb = wave >> 1;
#pragma unroll
        for (int q2 = 0; q2 < 2; ++q2) {
            const int sb = (wave & 1) * 2 + q2;
            pg8::f32x4 acc = {0.f, 0.f, 0.f, 0.f};
            if (sb <= jb) {
#pragma unroll
                for (int ks = 0; ks < 4; ++ks) acc = mfma16(*(const LAS half8*)(QL + (jb * 16 + fr) * 136 + ks * 32 + fq * 8), *(const LAS half8*)(KL + (sb * 16 + fr) * 136 + ks * 32 + fq * 8), acc);
            }
            const int s = sb * 16 + fr; const float as_ = aL[s];
#pragma unroll
            for (int r = 0; r < 4; ++r) {
                const int jj = jb * 16 + 4 * fq + r;
                const float pv = (s <= jj) ? acc[r] * __expf(bL[jj] - mjL[jj] + as_) : 0.f;
                PL[jj * 72 + s] = (h16)pv;
            }
        }
    }
    __syncthreads();
    {
        const int jb = wave >> 1;
#pragma unroll 1
        for (int e4 = 0; e4 < 4; ++e4) {
            const int eb = (wave & 1) * 4 + e4;
            pg8::f32x4 a1 = {0.f, 0.f, 0.f, 0.f}, a2 = {0.f, 0.f, 0.f, 0.f};
#pragma unroll
            for (int ks = 0; ks < 4; ++ks) a1 = mfma16(*(const LAS half8*)(QL + (jb * 16 + fr) * 136 + ks * 32 + fq * 8), *(const LAS half8*)(CTL + (eb * 16 + fr) * 136 + ks * 32 + fq * 8), a1);
#pragma unroll
            for (int ks = 0; ks < 2; ++ks) a2 = mfma16(*(const LAS half8*)(PL + (jb * 16 + fr) * 72 + ks * 32 + fq * 8), *(const LAS half8*)(VT + (eb * 16 + fr) * 72 + ks * 32 + fq * 8), a2);
#pragma unroll
            for (int r = 0; r < 4; ++r) { const int jj = jb * 16 + 4 * fq + r; HL[jj * 132 + eb * 16 + fr] = wiL[jj] * a1[r] + a2[r]; }
        }
        const int jj = tid >> 3, part = tid & 7;
        float qn = 0.f, ps = 0.f;
#pragma unroll
        for (int d = 0; d < 16; ++d) qn += (float)QL[jj * 136 + part * 16 + d] * nL[part * 16 + d];
#pragma unroll
        for (int s = 0; s < 8; ++s) ps += (float)PL[jj * 72 + part * 8 + s];
        qn += __shfl_xor(qn, 1); qn += __shfl_xor(qn, 2); qn += __shfl_xor(qn, 4);
        ps += __shfl_xor(ps, 1); ps += __shfl_xor(ps, 2); ps += __shfl_xor(ps, 4);
        if (part == 0) denL[jj] = wiL[jj] * qn + ps;
    }
    __syncthreads();
#pragma unroll 1
    for (int rr = 0; rr < 8; ++rr) {
        const int jj = wave * 8 + rr;
        const float dn = fmaxf(fabsf(denL[jj]), __expf(-mjL[jj]));
        const float h0 = HL[jj * 132 + lane] / dn, h1 = HL[jj * 132 + 64 + lane] / dn;
        float sm = h0 + h1; WAVE_SUM(sm);
        const float mean = sm * (1.f / 128.f), d0 = h0 - mean, d1 = h1 - mean;
        float vs = d0 * d0 + d1 * d1; WAVE_SUM(vs);
        const float rs = 1.0f / sqrtf(vs * (1.f / 128.f) + EPS);
        const size_t o = (r0 + jj) * 512 + h * 128;
        HM[o + lane] = (h16)(d0 * rs * hnorm[h * 128 + lane] * (float)OG[o + lane]);
        HM[o + 64 + lane] = (h16)(d1 * rs * hnorm[h * 128 + 64 + lane] * (float)OG[o + 64 + lane]);
    }
    __syncthreads();
}

#ifndef MK_SPLIT
#define MK_SPLIT 0
#endif
constexpr int NPHASE = 15;
__global__ void __launch_bounds__(NTHR, 2) hybrid_fwd(Args args) {
    extern __shared__ __attribute__((aligned(16))) unsigned char lds_raw[];
    LAS unsigned char* lds = (LAS unsigned char*)lds_raw;
    const int tid = threadIdx.x;
    const int G = gridDim.x; const int bx = blockIdx.x; const int vcu = (G % 8 == 0) ? (bx % 8) * (G / 8) + bx / 8 : bx;
    volatile LAS unsigned* MISC = (volatile LAS unsigned*)(lds + MISC_OFF);
    if (tid < 64) ((LAS unsigned*)(lds + MISC_OFF))[tid] = 0u;
    __syncthreads();
    unsigned char* ws = args.ws;
    gu32* ctl = (gu32*)(ws + WS_CTL);
    XcdBarrier bar; bar.bar = (unsigned*)(ctl + CW_BAR); bar.x = 0; bar.st = nullptr;
    if (!MK_SPLIT) bar = xcd_barrier_post((unsigned*)(ctl + CW_BAR), MISC + 8);
    const int lo = args.ph_lo, hi = args.ph_hi;
#define IN(k) (lo <= (k) && (k) < hi)
#define SEAM(k) do { if (IN(k) && IN((k) + 1)) xcd_barrier(bar); } while (0)
    float* xres = args.out;
    const float* MOD = (const float*)(ws + WS_MOD);
    h16* XN = (h16*)(ws + WS_XN); h16* HID = (h16*)(ws + WS_HID);

    if (IN(0)) { phase_prologue(args, lds, vcu, G); } SEAM(0);
    if (IN(1)) { phase_norm<0>(args, lds, vcu, G, args.in[0], args.in[4], 0, XN, nullptr); } SEAM(1);
    if (IN(2)) {
        pg8::Gemm g{(const pg8::bf16_t*)XN, (const pg8::bf16_t*)(ws + WS_W13A), MTOK, 2 * DFF, DM}; pg8::StaticOrder S; S.init(MTOK, 2 * DFF, G, bx);
        EpiSwiGLU E{HID};
        pg8::gemm_phase<EpiSwiGLU, pg8::StaticOrder, true, true>(lds, g, S, E);
    } SEAM(2);
    if (IN(3)) {
        pg8::Gemm g{(const pg8::bf16_t*)HID, (const pg8::bf16_t*)(ws + WS_W2A), MTOK, DM, DFF}; pg8::StaticOrder S; S.init(MTOK, DM, G, bx);
        EpiResid E{args.in[0], xres, MOD + 2 * 1024, 0.5f};
        pg8::gemm_phase<EpiResid, pg8::StaticOrder, true, true>(lds, g, S, E);
    } SEAM(3);
    if (IN(4)) { phase_norm<1>(args, lds, vcu, G, xres, args.in[8], 3, XN, nullptr); } SEAM(4);
    if (IN(5)) {
        pg8::Gemm g{(const pg8::bf16_t*)XN, (const pg8::bf16_t*)(ws + WS_WIN), MTOK, NWIN, DM}; pg8::StaticOrder S; S.init(MTOK, NWIN, G, bx);
        EpiWin E{ws, args.in[15]};
        pg8::gemm_phase<EpiWin, pg8::StaticOrder, true, true>(lds, g, S, E);
    } SEAM(5);
    if (IN(6)) {
        kv_finalize(args, vcu, G);
        phase_indexer(args, lds, vcu, G);
        for (int u = vcu; u < 1024; u += G) mlstmA_unit(args, lds, u);
    } SEAM(6);
    if (IN(7)) {
        phase_sattn(args, lds, vcu, G);
        phase_mlstmB(args, lds, vcu, G);
    } SEAM(7);
    if (IN(8)) { for (int u = vcu; u < 1024; u += G) mlstmC_unit(args, lds, u); } SEAM(8);
    if (IN(9)) {
        pg8::StaticOrder S; S.init(MTOK, DM, G, bx);
        { pg8::Gemm g{(const pg8::bf16_t*)(ws + WS_YA), (const pg8::bf16_t*)(ws + WS_WBA), MTOK, DM, 512};
          EpiMerge<false> E{(const h16*)(ws + WS_GA), (h16*)(ws + WS_MRG)};
          pg8::gemm_phase<EpiMerge<false>, pg8::StaticOrder, true, true>(lds, g, S, E); }
        __syncthreads();
        { pg8::Gemm g{(const pg8::bf16_t*)(ws + WS_HM), (const pg8::bf16_t*)(ws + WS_WBM), MTOK, DM, 512};
          EpiMerge<true> E{(const h16*)(ws + WS_GM), (h16*)(ws + WS_MRG)};
          pg8::gemm_phase<EpiMerge<true>, pg8::StaticOrder, true, true>(lds, g, S, E); }
    } SEAM(9);
    if (IN(10)) {
        pg8::Gemm g{(const pg8::bf16_t*)(ws + WS_MRG), (const pg8::bf16_t*)(ws + WS_WOUT), MTOK, DM, DM}; pg8::StaticOrder S; S.init(MTOK, DM, G, bx);
        EpiResid E{xres, xres, MOD + 5 * 1024, 1.0f};
        pg8::gemm_phase<EpiResid, pg8::StaticOrder, true, true>(lds, g, S, E);
    } SEAM(10);
    if (IN(11)) { phase_norm<1>(args, lds, vcu, G, xres, args.in[21], 6, XN, nullptr); convert_ffn2_weights(args, lds, vcu, G); } SEAM(11);
    if (IN(12)) {
        pg8::Gemm g{(const pg8::bf16_t*)XN, (const pg8::bf16_t*)(ws + WS_W13B), MTOK, 2 * DFF, DM}; pg8::StaticOrder S; S.init(MTOK, 2 * DFF, G, bx);
        EpiSwiGLU E{HID};
        pg8::gemm_phase<EpiSwiGLU, pg8::StaticOrder, true, true>(lds, g, S, E);
    } SEAM(12);
    if (IN(13)) {
        pg8::Gemm g{(const pg8::bf16_t*)HID, (const pg8::bf16_t*)(ws + WS_W2B), MTOK, DM, DFF}; pg8::StaticOrder S; S.init(MTOK, DM, G, bx);
        EpiResid E{xres, xres, MOD + 8 * 1024, 0.5f};
        pg8::gemm_phase<EpiResid, pg8::StaticOrder, true, true>(lds, g, S, E);
    } SEAM(13);
    if (IN(14)) { phase_norm<2>(args, lds, vcu, G, xres, args.in[25], 0, nullptr, xres); }
#undef IN
#undef SEAM
}

extern "C" void kernel_launch(void* const* d_in, const int* in_sizes, int n_in, void* d_out, int out_size, void* d_ws, size_t ws_size, hipStream_t stream) {
    static int grid = 0;
    if (grid == 0) {
        if (n_in != 26 || out_size != MTOK * DM || ws_size < WS_END) { fprintf(stderr, "kernel_launch: unexpected shapes (n_in %d out %d ws %zu)\n", n_in, out_size, ws_size); grid = -1; return; }
        int dev = 0, cus = 0, per_cu = 0;
        if (hipGetDevice(&dev) != hipSuccess || hipDeviceGetAttribute(&cus, hipDeviceAttributeMultiprocessorCount, dev) != hipSuccess) { grid = -1; return; }
        if (hipFuncSetAttribute((const void*)hybrid_fwd, hipFuncAttributeMaxDynamicSharedMemorySize, LDS_BYTES) != hipSuccess) { fprintf(stderr, "kernel_launch: hipFuncSetAttribute failed\n"); grid = -1; return; }
        if (hipOccupancyMaxActiveBlocksPerMultiprocessor(&per_cu, (const void*)hybrid_fwd, NTHR, LDS_BYTES) != hipSuccess || per_cu < 1) { fprintf(stderr, "kernel_launch: occupancy query says %d blocks per CU\n", per_cu); per_cu = 1; }
        (void)hipGetLastError();
        grid = cus;
    }
    if (grid < 0) return;
    (void)hipMemsetAsync((char*)d_ws + WS_CTL, 0, CTL_ZERO_BYTES, stream);
    Args a{};
    for (int i = 0; i < 26; ++i) a.in[i] = (const float*)d_in[i];
    a.out = (float*)d_out; a.ws = (unsigned char*)d_ws;
#if MK_SPLIT
    for (int p = 0; p < NPHASE; ++p) { a.ph_lo = p; a.ph_hi = p + 1; hipLaunchKernelGGL(hybrid_fwd, dim3(grid), dim3(NTHR), LDS_BYTES, stream, a); }
#else
    a.ph_lo = 0; a.ph_hi = NPHASE;
    hipLaunchKernelGGL(hybrid_fwd, dim3(grid), dim3(NTHR), LDS_BYTES, stream, a);
#endif
}
```

```cpp
#include <hip/hip_runtime.h>
#include <cstdio>
#include <cstdint>
#include <cmath>
typedef _Float16 h16;
typedef _Float16 half8 __attribute__((ext_vector_type(8)));
typedef _Float16 half4 __attribute__((ext_vector_type(4)));
namespace pg8 {
typedef _Float16 half8 __attribute__((ext_vector_type(8)));
#define PG8_LAS __attribute__((address_space(3)))
typedef unsigned short bf16_t;
typedef short bf16x8 __attribute__((ext_vector_type(8)));
typedef float f32x4 __attribute__((ext_vector_type(4)));
typedef unsigned u32x4 __attribute__((ext_vector_type(4)));
constexpr int BM = 256, BK = 64, HALF = 128, HTB = HALF * BK * 2  , STAGE_BYTES = 8 * HTB, NXCD = 8, WGM = 8;

__host__ __device__ __forceinline__ int lds_byte(int r, int c) { const int st = (r >> 4) * 2 + (c >> 5), rr = r & 15, cc = c & 31, ob = rr * 64 + cc * 2; return st * 1024 + (ob ^ (((ob >> 9) & 1) << 5)); }
__host__ __device__ __forceinline__ void stage_rc(int b, int& R, int& C) { const int st = b / 1024, sb = b % 1024, swz = sb ^ (((sb >> 9) & 1) << 5); R = (st >> 1) * 16 + swz / 64; C = (st & 1) * 32 + (swz % 64) / 2; }
__host__ __device__ __forceinline__ int perm32(int rho) { const int n = rho >> 4, i = rho & 15; return 8 * (i >> 2) + 4 * n + (i & 3); }

struct Unit { int pm, pn; };
struct Gemm { const bf16_t* A; const bf16_t* Bt; int M, N, K; };

struct StaticOrder {
    int nM, nN, nwg, G, c;
    __host__ __device__ void init(int M, int N, int G_, int c_) { nM = M / BM; nN = N / BM; nwg = nM * nN; G = G_; c = c_; }
    __host__ __device__ bool next(int i, Unit& u) const {
        const long L = (long)i * G + c; if (L >= nwg) return false;
        int wgid = (int)L; { const int q = nwg / NXCD, r = nwg % NXCD, xcd = wgid % NXCD, off = wgid / NXCD; wgid = (xcd < r ? xcd * (q + 1) : r * (q + 1) + (xcd - r) * q) + off; }
        const int nig = WGM * nN, gid = wgid / nig, fm = gid * WGM, gsz = (nM - fm) < WGM ? (nM - fm) : WGM;
        u.pm = fm + ((wgid % nig) % gsz); u.pn = (wgid % nig) / gsz; return true;
    }
    __device__ __forceinline__ void a_ready(const Unit&) const {}
    __device__ __forceinline__ void done(const Unit&) const {}
};
template <class Epi, class Sched, bool ALIGN_EPI = false, bool SP2 = false>
__device__ __forceinline__ void gemm_phase(PG8_LAS unsigned char* lds, const Gemm g, const Sched& S, const Epi& E) {
    const int tid = threadIdx.x, wid = __builtin_amdgcn_readfirstlane(tid >> 6), lane = tid & 63, wr = wid >> 2, wc = wid & 3, fr = lane & 15, fq = lane >> 4;
    const int K = g.K, nt = K / BK;
    unsigned voffA[2], voffB[2];
#pragma unroll
    for (int i = 0; i < 2; ++i) { int R, C; stage_rc(tid * 16 + i * 8192, R, C); const int Rb = Epi::PERM ? ((R & ~31) + perm32(R & 31)) : R;
        voffA[i] = (unsigned)(R * K + C) * 2u; voffB[i] = (unsigned)(Rb * K + C) * 2u; }
    const size_t kstep = (size_t)(BK * 2);
    const size_t hstep = (size_t)HALF * K * 2;
    const size_t tstep = 2 * hstep;
    const unsigned ldsw = (unsigned)wid * 1024u;
    const int aoff = lds_byte(wr * 64 + fr, fq * 8), boff = lds_byte(wc * 32 + fr, fq * 8);
#define PG8_SA(b, h) (((b) * 2 + (h)) * HTB)
#define PG8_SB(b, h) ((4 + (b) * 2 + (h)) * HTB)
#define PG8_STAGE(bufoff, gbase, voff) do { _Pragma("unroll") for (int _i = 0; _i < 2; ++_i) \
        __builtin_amdgcn_global_load_lds((const unsigned*)((const char*)(gbase) + (voff)[_i]), (PG8_LAS unsigned*)(lds + (bufoff) + ldsw + _i * 8192), 16, 0, 0); } while (0)
#define PG8_LDA(dst, b, h) do { _Pragma("unroll") for (int m = 0; m < 4; ++m) _Pragma("unroll") for (int k = 0; k < 2; ++k) dst[m][k] = *(const PG8_LAS bf16x8*)(lds + PG8_SA(b, h) + aoff + m * 2048 + k * 1024); } while (0)
#define PG8_LDB(dst, b, h) do { _Pragma("unroll") for (int n = 0; n < 2; ++n) _Pragma("unroll") for (int k = 0; k < 2; ++k) dst[n][k] = *(const PG8_LAS bf16x8*)(lds + PG8_SB(b, h) + boff + n * 2048 + k * 1024); } while (0)
#define PG8_MMA(ai, bj, At, Bt) do { __builtin_amdgcn_s_setprio(1); _Pragma("unroll") for (int m = 0; m < 4; ++m) _Pragma("unroll") for (int n = 0; n < 2; ++n) _Pragma("unroll") for (int k = 0; k < 2; ++k) \
        acc[ai][bj][m][n] = __builtin_amdgcn_mfma_f32_16x16x32_f16(__builtin_bit_cast(half8, Bt[n][k]), __builtin_bit_cast(half8, At[m][k]), acc[ai][bj][m][n], 0, 0, 0); __builtin_amdgcn_s_setprio(0); } while (0)
#define PG8_WAIT_V(n) asm volatile("s_waitcnt vmcnt(" #n ")" ::: "memory")
#define PG8_WAIT_L(n) asm volatile("s_waitcnt lgkmcnt(" #n ")" ::: "memory")
#define PG8_BAR __builtin_amdgcn_s_barrier()
#define PG8_SCHED __builtin_amdgcn_sched_barrier(0)
    Unit cur, nxt; int ui = 0;
    if (!S.next(0, cur)) return;
    f32x4 acc[2][2][4][2];
#pragma unroll
    for (int a = 0; a < 2; ++a)
#pragma unroll
        for (int b = 0; b < 2; ++b)
#pragma unroll
            for (int m = 0; m < 4; ++m)
#pragma unroll
                for (int n = 0; n < 2; ++n) acc[a][b][m][n] = (f32x4){0.f, 0.f, 0.f, 0.f};
    bf16x8 At[4][2], B0[2][2], B1[2][2];
    const char* cA = (const char*)g.A + (size_t)cur.pm * tstep; const char* cB = (const char*)g.Bt + (size_t)cur.pn * tstep;
    S.a_ready(cur);
    if constexpr (SP2) {
        PG8_STAGE(PG8_SB(0, 0), cB, voffB); PG8_STAGE(PG8_SB(0, 1), cB + hstep, voffB); PG8_STAGE(PG8_SA(0, 0), cA, voffA); PG8_STAGE(PG8_SA(0, 1), cA + hstep, voffA);
        if (wr == 1) PG8_BAR;
        PG8_WAIT_V(2); PG8_BAR;
        PG8_STAGE(PG8_SB(1, 0), cB + kstep, voffB); PG8_STAGE(PG8_SA(1, 0), cA + kstep, voffA); PG8_STAGE(PG8_SB(1, 1), cB + hstep + kstep, voffB);
        PG8_WAIT_V(6); PG8_BAR;
    } else {
        PG8_STAGE(PG8_SB(0, 0), cB, voffB); PG8_STAGE(PG8_SA(0, 0), cA, voffA); PG8_STAGE(PG8_SB(0, 1), cB + hstep, voffB); PG8_STAGE(PG8_SA(0, 1), cA + hstep, voffA);
        if (wr == 1) PG8_BAR;
        PG8_WAIT_V(4); PG8_BAR;
        PG8_STAGE(PG8_SB(1, 0), cB + kstep, voffB); PG8_STAGE(PG8_SA(1, 0), cA + kstep, voffA); PG8_STAGE(PG8_SB(1, 1), cB + hstep + kstep, voffB);
        PG8_WAIT_V(6); PG8_BAR;
    }
    for (;;) {
        const bool has_next = S.next(ui + 1, nxt);
        const char* nA = has_next ? (const char*)g.A + (size_t)nxt.pm * tstep : cA; const char* nB = has_next ? (const char*)g.Bt + (size_t)nxt.pn * tstep : cB;
        for (int t = 0; t < nt; t += 2) {
            const bool last = (t == nt - 2);
            const char* a1 = cA + (size_t)(t + 1) * kstep;
            const char* a2 = last ? nA : cA + (size_t)(t + 2) * kstep; const char* b2 = last ? nB : cB + (size_t)(t + 2) * kstep;
            const char* a3 = a2 + kstep; const char* b3 = b2 + kstep;
            if (last && has_next) S.a_ready(nxt);
            if constexpr (SP2) {
            PG8_LDB(B0, 0, 0); PG8_LDB(B1, 0, 1); PG8_SCHED; PG8_LDA(At, 0, 0); PG8_STAGE(PG8_SA(1, 1), a1 + hstep, voffA);
            PG8_WAIT_V(8); PG8_WAIT_L(0); PG8_BAR; PG8_MMA(0, 0, At, B0); PG8_MMA(0, 1, At, B1); PG8_BAR; PG8_SCHED;
            PG8_LDA(At, 0, 1); PG8_STAGE(PG8_SB(0, 0), b2, voffB); PG8_STAGE(PG8_SB(0, 1), b2 + hstep, voffB); PG8_STAGE(PG8_SA(0, 0), a2, voffA);
            PG8_WAIT_V(8); PG8_WAIT_L(0); PG8_BAR; PG8_MMA(1, 0, At, B0); PG8_MMA(1, 1, At, B1); PG8_BAR; PG8_SCHED;
            PG8_LDB(B0, 1, 0); PG8_LDB(B1, 1, 1); PG8_SCHED; PG8_LDA(At, 1, 0); PG8_STAGE(PG8_SA(0, 1), a2 + hstep, voffA);
            PG8_WAIT_V(8); PG8_WAIT_L(0); PG8_BAR; PG8_MMA(0, 0, At, B0); PG8_MMA(0, 1, At, B1); PG8_BAR; PG8_SCHED;
            PG8_LDA(At, 1, 1); PG8_STAGE(PG8_SB(1, 0), b3, voffB); PG8_STAGE(PG8_SB(1, 1), b3 + hstep, voffB); PG8_STAGE(PG8_SA(1, 0), a3, voffA);
            PG8_WAIT_V(8); PG8_WAIT_L(0); PG8_BAR; PG8_MMA(1, 0, At, B0); PG8_MMA(1, 1, At, B1); PG8_BAR; PG8_SCHED;
            } else {
            PG8_LDB(B0, 0, 0); PG8_SCHED; PG8_LDA(At, 0, 0); PG8_STAGE(PG8_SA(1, 1), a1 + hstep, voffA);
            PG8_WAIT_L(8); PG8_BAR; PG8_WAIT_L(0); PG8_MMA(0, 0, At, B0); PG8_BAR; PG8_SCHED;
            PG8_LDB(B1, 0, 1); PG8_STAGE(PG8_SB(0, 0), b2, voffB);
            PG8_BAR; PG8_WAIT_L(0); PG8_MMA(0, 1, At, B1); PG8_BAR;
            PG8_LDA(At, 0, 1); PG8_STAGE(PG8_SA(0, 0), a2, voffA);
            PG8_BAR; PG8_WAIT_L(0); PG8_MMA(1, 0, At, B0); PG8_BAR; PG8_SCHED;
            PG8_STAGE(PG8_SB(0, 1), b2 + hstep, voffB);
            PG8_WAIT_V(6); PG8_BAR; PG8_MMA(1, 1, At, B1); PG8_BAR;
            PG8_LDB(B0, 1, 0); PG8_SCHED; PG8_LDA(At, 1, 0); PG8_STAGE(PG8_SA(0, 1), a2 + hstep, voffA);
            PG8_WAIT_L(8); PG8_BAR; PG8_WAIT_L(0); PG8_MMA(0, 0, At, B0); PG8_BAR; PG8_SCHED;
            PG8_LDB(B1, 1, 1); PG8_STAGE(PG8_SB(1, 0), b3, voffB);
            PG8_BAR; PG8_WAIT_L(0); PG8_MMA(0, 1, At, B1); PG8_BAR;
            PG8_LDA(At, 1, 1); PG8_STAGE(PG8_SA(1, 0), a3, voffA);
            PG8_BAR; PG8_WAIT_L(0); PG8_MMA(1, 0, At, B0); PG8_BAR; PG8_SCHED;
            PG8_STAGE(PG8_SB(1, 1), b3 + hstep, voffB);
            PG8_WAIT_V(6); PG8_BAR; PG8_MMA(1, 1, At, B1); PG8_BAR;
            }
        }
        if constexpr (ALIGN_EPI) { if (wr == 0) PG8_BAR; }
        if constexpr (!Epi::AFTER_DRAIN) { E(acc, cur, wr, wc, fr, fq); S.done(cur); }
        if (!has_next) break;
#pragma unroll
        for (int a = 0; a < 2; ++a)
#pragma unroll
            for (int b = 0; b < 2; ++b)
#pragma unroll
                for (int m = 0; m < 4; ++m)
#pragma unroll
                    for (int n = 0; n < 2; ++n) acc[a][b][m][n] = (f32x4){0.f, 0.f, 0.f, 0.f};
        cur = nxt; cA = nA; cB = nB; ++ui;
        if constexpr (ALIGN_EPI) { if (wr == 1) PG8_BAR; }
    }
    PG8_WAIT_V(0);
    if constexpr (!ALIGN_EPI) { if (wr == 0) PG8_BAR; }
    PG8_BAR;
    if constexpr (Epi::AFTER_DRAIN) { E.fused(acc, cur, wr, wc, fr, fq, lds, wid, lane); S.done(cur); }
#undef PG8_SA
#undef PG8_SB
#undef PG8_STAGE
#undef PG8_LDA
#undef PG8_LDB
#undef PG8_MMA
#undef PG8_WAIT_V
#undef PG8_WAIT_L
#undef PG8_BAR
#undef PG8_SCHED
}
}
#define GAS __attribute__((address_space(1)))
#define LAS __attribute__((address_space(3)))
typedef unsigned short bf16;
typedef unsigned v4u __attribute__((ext_vector_type(4)));
typedef float f32x4 __attribute__((ext_vector_type(4)));
typedef short bf16x8 __attribute__((ext_vector_type(8)));
typedef GAS unsigned gu32;
typedef GAS unsigned long long gu64;
#define RLX_AGENT __ATOMIC_RELAXED, __HIP_MEMORY_SCOPE_AGENT
#define LDS_WAIT() asm volatile("s_waitcnt lgkmcnt(0)" ::: "memory")
#define VM_WAIT() asm volatile("s_waitcnt vmcnt(0)" ::: "memory")
__device__ __forceinline__ unsigned long long rt() { return __builtin_amdgcn_s_memrealtime(); }
__device__ __forceinline__ unsigned f2bf(float f) { unsigned u = __builtin_bit_cast(unsigned, f); return (u + 0x7fffu + ((u >> 16) & 1u)) >> 16; }
__device__ __forceinline__ unsigned pk2(float lo, float hi) { return f2bf(lo) | (f2bf(hi) << 16); }

#define XB_TMO      128
#define XB_XCNT(j)  (256  + 64 * (j))
#define XB_XSUB(j)  (1280 + 64 * (j))
#define XB_XGEN(j)  (2304 + 64 * (j))
#define XB_TOP      3328
#define XB_TOPGEN   3392
#define XCD_BAR_WORDS 3456
#define XB_SPIN_CAP (1u << 18)

__device__ __forceinline__ unsigned xb_ld(unsigned* p)              { return __hip_atomic_load(p, __ATOMIC_RELAXED, __HIP_MEMORY_SCOPE_AGENT); }
__device__ __forceinline__ unsigned xb_add(unsigned* p, unsigned v) { return __hip_atomic_fetch_add(p, v, __ATOMIC_RELAXED, __HIP_MEMORY_SCOPE_AGENT); }
__device__ __forceinline__ unsigned xb_xcc_id() { return (unsigned)__builtin_amdgcn_s_getreg((3 << 11) | 20) & 0xFu; }
#define XB_SPIN(cond, bar) do { unsigned _sp = 0; while (cond) { __builtin_amdgcn_s_sleep(1); \
    if ((++_sp & 255u) == 0u) { if (xb_ld(&(bar)[XB_TMO])) break; if (_sp > XB_SPIN_CAP) { atomicAdd(&(bar)[XB_TMO], 1u); break; } } } } while (0)

struct XcdBarrier {
    unsigned* bar; unsigned x;
    volatile LAS unsigned* st;
};

__device__ __forceinline__ XcdBarrier xcd_barrier_post(unsigned* bar, volatile LAS unsigned* st) {
    XcdBarrier b; b.bar = bar; b.x = xb_xcc_id(); b.st = st;
    if (threadIdx.x == 0) (void)xb_add(&bar[XB_XCNT(b.x)], 1u);
    return b;
}
__device__ __forceinline__ void xcd_barrier_complete(unsigned* bar, unsigned x, unsigned& nloc, unsigned& nx) {
    const unsigned G = gridDim.x * gridDim.y * gridDim.z;
    unsigned sum, cnt, mine, sp = 0u;
    for (;;) {
        sum = 0u; cnt = 0u; mine = 0u;
#pragma unroll
        for (unsigned j = 0; j < 16; ++j) { const unsigned c = xb_ld(&bar[XB_XCNT(j)]); sum += c; cnt += (c > 0u) ? 1u : 0u; mine = (j == x) ? c : mine; }
        if (sum == G) break;
        __builtin_amdgcn_s_sleep(1);
        if ((++sp & 255u) == 0u) { if (xb_ld(&bar[XB_TMO])) break; if (sp > XB_SPIN_CAP) { atomicAdd(&bar[XB_TMO], 1u); break; } }
    }
    nloc = mine > 0u ? mine : 1u; nx = cnt > 0u ? cnt : 1u;
}

__device__ __forceinline__ void xcd_barrier(const XcdBarrier& b) {
    asm volatile("s_waitcnt vmcnt(0)" ::: "memory");
    __syncthreads();
    if (threadIdx.x == 0) {
        unsigned* bar = b.bar;
        __builtin_amdgcn_s_waitcnt(0);
        unsigned nloc = b.st[0], nx = b.st[1];
        if (nloc == 0u) { xcd_barrier_complete(bar, b.x, nloc, nx); b.st[0] = nloc; b.st[1] = nx; }
        const unsigned old = xb_add(&bar[XB_XSUB(b.x)], 1u);
        const unsigned gen = old / nloc;
        if (old + 1u == (gen + 1u) * nloc) {
            __builtin_amdgcn_fence(__ATOMIC_RELEASE, "agent");
            asm volatile("s_waitcnt vmcnt(0)" ::: "memory");
            const unsigned og = xb_add(&bar[XB_TOP], 1u);
            const unsigned tg = og / nx;
            if (og + 1u == (tg + 1u) * nx) xb_add(&bar[XB_TOPGEN], 1u);
            else XB_SPIN(xb_ld(&bar[XB_TOPGEN]) == tg, bar);
            __builtin_amdgcn_fence(__ATOMIC_ACQUIRE, "agent");
            xb_add(&bar[XB_XGEN(b.x)], 1u);
            asm volatile("s_waitcnt vmcnt(0)" ::: "memory");
        } else {
            XB_SPIN(xb_ld(&bar[XB_XGEN(b.x)]) == gen, bar);
            __builtin_amdgcn_fence(__ATOMIC_ACQUIRE, "agent");
            asm volatile("s_waitcnt vmcnt(0)" ::: "memory");
        }
    }
    __syncthreads();
}

constexpr int BATCH = 2, SEQ = 8192, DM = 1024, MTOK = BATCH * SEQ;
constexpr int DLAT = 256, TOPK = 256, DFF = 2816, DIN = 5456, NWIN = 5632;
constexpr int NWAVES = 8, NTHR = 512;
constexpr float EPS = 1e-6f;
constexpr float IDX_SCALE = 0.04419417382415922f;
constexpr int NKS = 16;

constexpr size_t MiB = 1u << 20;
constexpr size_t WS_CTL = 0, CTL_ZERO_BYTES = 1 * MiB;
constexpr size_t WS_W13A = 1 * MiB;
constexpr size_t WS_W2A  = 12 * MiB;
constexpr size_t WS_WIN  = 18 * MiB;
constexpr size_t WS_WBA  = 29 * MiB;
constexpr size_t WS_WBM  = 30 * MiB;
constexpr size_t WS_WOUT = 31 * MiB;
constexpr size_t WS_WUK  = 33 * MiB;
constexpr size_t WS_WUVT = 33 * MiB + 256 * 1024;
constexpr size_t WS_MODP = 33 * MiB + 512 * 1024;
constexpr size_t WS_MOD  = 34 * MiB + 768 * 1024;
constexpr size_t WS_XN   = 35 * MiB;
constexpr size_t WS_HID  = 67 * MiB;
constexpr size_t WS_QA   = 67 * MiB;
constexpr size_t WS_CKV  = 83 * MiB;
constexpr size_t WS_QIDX = 91 * MiB;
constexpr size_t WS_KIDX = 107 * MiB;
constexpr size_t WS_WIDX = 109 * MiB;
constexpr size_t WS_GI   = 109 * MiB + 512 * 1024;
constexpr size_t WS_GF   = 109 * MiB + 768 * 1024;
constexpr size_t WS_QM   = 110 * MiB;
constexpr size_t WS_KM   = 126 * MiB;
constexpr size_t WS_VM   = 142 * MiB;
constexpr size_t WS_OG   = 158 * MiB;
constexpr size_t WS_GA   = 174 * MiB;
constexpr size_t WS_GM   = 206 * MiB;
constexpr size_t WS_Q2   = 238 * MiB;
constexpr size_t WS_SEL  = 1 * MiB;
constexpr size_t WS_K2   = 9 * MiB;
constexpr size_t WS_NVEC = 25 * MiB;
constexpr size_t WS_MLOC = 25 * MiB + 512 * 1024;
constexpr size_t WS_BLAST= 25 * MiB + 520 * 1024;
constexpr size_t WS_NST  = 26 * MiB;
constexpr size_t WS_MST  = 26 * MiB + 512 * 1024;
constexpr size_t WS_UT   = 35 * MiB;
constexpr size_t WS_YA   = 91 * MiB;
constexpr size_t WS_CT   = 110 * MiB;
constexpr size_t WS_HM   = 35 * MiB;
constexpr size_t WS_MRG  = 110 * MiB;
constexpr size_t WS_W13B = 1 * MiB;
constexpr size_t WS_W2B  = 12 * MiB;
constexpr size_t WS_END  = 256 * MiB;

constexpr int CW_BAR = 4096;

constexpr int LDS_BYTES = 160 * 1024;
constexpr int MISC_OFF = LDS_BYTES - 256;

#define WAVE_SUM(v) do { _Pragma("unroll") for (int _o = 1; _o < 64; _o <<= 1) v += __shfl_xor(v, _o); } while (0)
#define WAVE_MAX(v) do { _Pragma("unroll") for (int _o = 1; _o < 64; _o <<= 1) v = fmaxf(v, __shfl_xor(v, _o)); } while (0)

typedef unsigned u32x4 __attribute__((ext_vector_type(4)));
typedef unsigned u32x2 __attribute__((ext_vector_type(2)));

__device__ __forceinline__ float silu_f(float a) { return a * __builtin_amdgcn_rcpf(1.f + __expf(-a)); }
__device__ __forceinline__ float sigmoid_f(float a) { return __builtin_amdgcn_rcpf(1.f + __expf(-a)); }
__device__ __forceinline__ float logsigmoid_f(float x) { return fminf(x, 0.f) - log1pf(__expf(-fabsf(x))); }
__device__ __forceinline__ half8 pack8(const float* v) { half8 r; _Pragma("unroll") for (int i = 0; i < 8; ++i) r[i] = (h16)v[i]; return r; }
__device__ __forceinline__ f32x4 mfma16(half8 a, half8 b, f32x4 c) { return __builtin_amdgcn_mfma_f32_16x16x32_f16(a, b, c, 0, 0, 0); }

struct Args { const float* in[26]; float* out; unsigned char* ws; int ph_lo, ph_hi; };

struct EpiSwiGLU {
    static constexpr bool PERM = true, AFTER_DRAIN = false;
    h16* O;
    __device__ __forceinline__ void operator()(const pg8::f32x4 (&acc)[2][2][4][2], const pg8::Unit& u, int wr, int wc, int fr, int fq) const {
        const int row0 = u.pm * 256 + wr * 64 + fr, col0 = u.pn * 128 + wc * 32 + 8 * fq;
#pragma unroll
        for (int ai = 0; ai < 2; ++ai)
#pragma unroll
            for (int m = 0; m < 4; ++m) {
                h16* rowp = O + (size_t)(row0 + ai * 128 + m * 16) * DFF + col0;
                float r[8];
#pragma unroll
                for (int n = 0; n < 2; ++n)
#pragma unroll
                    for (int i = 0; i < 4; ++i) r[n * 4 + i] = silu_f(acc[ai][0][m][n][i]) * acc[ai][1][m][n][i];
                *(half8*)rowp = pack8(r);
            }
    }
};
struct EpiResid {
    static constexpr bool PERM = false, AFTER_DRAIN = false;
    const float* res; float* out; const float* gmod; float gs;
    __device__ __forceinline__ void operator()(const pg8::f32x4 (&acc)[2][2][4][2], const pg8::Unit& u, int wr, int wc, int fr, int fq) const {
        const int row0 = u.pm * 256 + wr * 64 + fr, col0 = u.pn * 256 + wc * 32 + 4 * fq;
        const float* gp = gmod + (size_t)(u.pm >> 5) * 9216 + col0;
        pg8::f32x4 g[2][2];
#pragma unroll
        for (int bj = 0; bj < 2; ++bj)
#pragma unroll
            for (int n = 0; n < 2; ++n) g[bj][n] = *(const pg8::f32x4*)(gp + bj * 128 + n * 16) * gs;
#pragma unroll
        for (int ai = 0; ai < 2; ++ai)
#pragma unroll
            for (int m = 0; m < 4; ++m) {
                const size_t off = (size_t)(row0 + ai * 128 + m * 16) * DM + col0;
#pragma unroll
                for (int bj = 0; bj < 2; ++bj)
#pragma unroll
                    for (int n = 0; n < 2; ++n) {
                        const pg8::f32x4 rv = *(const pg8::f32x4*)(res + off + bj * 128 + n * 16);
                        *(pg8::f32x4*)(out + off + bj * 128 + n * 16) = rv + g[bj][n] * acc[ai][bj][m][n];
                    }
            }
    }
};
struct EpiWin {
    static constexpr bool PERM = true, AFTER_DRAIN = false;
    unsigned char* ws; const float* gate_bias;
    __device__ __forceinline__ void operator()(const pg8::f32x4 (&acc)[2][2][4][2], const pg8::Unit& u, int wr, int wc, int fr, int fq) const {
        const int pn = u.pn;
        const int row0 = u.pm * 256 + wr * 64 + fr, cc0 = wc * 32 + 8 * fq;
        if (pn == 5) {
            h16* KIDX = (h16*)(ws + WS_KIDX); float* WIDX = (float*)(ws + WS_WIDX); float* GI = (float*)(ws + WS_GI); float* GF = (float*)(ws + WS_GF);
#pragma unroll
            for (int ai = 0; ai < 2; ++ai)
#pragma unroll
                for (int m = 0; m < 4; ++m) {
                    const int row = row0 + ai * 128 + m * 16;
                    if (cc0 < 64) {
                        float r[8];
#pragma unroll
                        for (int n = 0; n < 2; ++n)
#pragma unroll
                            for (int i = 0; i < 4; ++i) r[n * 4 + i] = acc[ai][0][m][n][i];
                        *(half8*)(KIDX + (size_t)row * 64 + cc0) = pack8(r);
                    } else if (cc0 == 64) {
#pragma unroll
                        for (int n = 0; n < 2; ++n) *(pg8::f32x4*)(WIDX + (size_t)row * 8 + n * 4) = acc[ai][0][m][n] * IDX_SCALE;
                    } else if (cc0 == 72) {
                        pg8::f32x4 gi, gf;
#pragma unroll
                        for (int i = 0; i < 4; ++i) { gi[i] = acc[ai][0][m][0][i] + gate_bias[i]; gf[i] = logsigmoid_f(acc[ai][0][m][1][i] + gate_bias[4 + i]); }
                        *(pg8::f32x4*)(GI + (size_t)row * 4) = gi; *(pg8::f32x4*)(GF + (size_t)row * 4) = gf;
                    }
                }
            return;
        }
        size_t dst; int ld, cb; bool sg = false;
        if (pn < 2)       { dst = WS_QA;   ld = 512;  cb = pn * 256; }
        else if (pn == 2) { dst = WS_CKV;  ld = 256;  cb = 0; }
        else if (pn < 5)  { dst = WS_QIDX; ld = 512;  cb = (pn - 3) * 256; }
        else if (pn < 8)  { dst = WS_QM;   ld = 512;  cb = (pn - 6) * 256; }
        else if (pn < 10) { dst = WS_KM;   ld = 512;  cb = (pn - 8) * 256; }
        else if (pn < 12) { dst = WS_VM;   ld = 512;  cb = (pn - 10) * 256; }
        else if (pn < 14) { dst = WS_OG;   ld = 512;  cb = (pn - 12) * 256; sg = true; }
        else if (pn < 18) { dst = WS_GA;   ld = 1024; cb = (pn - 14) * 256; sg = true; }
        else              { dst = WS_GM;   ld = 1024; cb = (pn - 18) * 256; sg = true; }
        h16* O = (h16*)(ws + dst);
#pragma unroll
        for (int ai = 0; ai < 2; ++ai)
#pragma unroll
            for (int m = 0; m < 4; ++m) {
                h16* rowp = O + (size_t)(row0 + ai * 128 + m * 16) * ld + cb + cc0;
#pragma unroll
                for (int bj = 0; bj < 2; ++bj) {
                    float r[8];
#pragma unroll
                    for (int n = 0; n < 2; ++n)
#pragma unroll
                        for (int i = 0; i < 4; ++i) { const float v = acc[ai][bj][m][n][i]; r[n * 4 + i] = sg ? sigmoid_f(v) : v; }
                    *(half8*)(rowp + bj * 128) = pack8(r);
                }
            }
    }
};
template <bool ACCUM> struct EpiMerge {
    static constexpr bool PERM = true, AFTER_DRAIN = false;
    const h16* gate; h16* O;
    __device__ __forceinline__ void operator()(const pg8::f32x4 (&acc)[2][2][4][2], const pg8::Unit& u, int wr, int wc, int fr, int fq) const {
        const int row0 = u.pm * 256 + wr * 64 + fr, col0 = u.pn * 256 + wc * 32 + 8 * fq;
#pragma unroll
        for (int ai = 0; ai < 2; ++ai)
#pragma unroll
            for (int m = 0; m < 4; ++m) {
                const size_t off = (size_t)(row0 + ai * 128 + m * 16) * DM + col0;
#pragma unroll
                for (int bj = 0; bj < 2; ++bj) {
                    const half8 gv = *(const half8*)(gate + off + bj * 128);
                    half8 ov; if (ACCUM) ov = *(const half8*)(O + off + bj * 128);
                    float r[8];
#pragma unroll
                    for (int n = 0; n < 2; ++n)
#pragma unroll
                        for (int i = 0; i < 4; ++i) { float v = (float)gv[n * 4 + i] * acc[ai][bj][m][n][i]; if (ACCUM) v += (float)ov[n * 4 + i]; r[n * 4 + i] = v; }
                    *(half8*)(O + off + bj * 128) = pack8(r);
                }
            }
    }
};

template <int MAP> __device__ __forceinline__ int wmap(int j) {
    if (MAP == 0) return j;
    if (MAP == 1) return 256 * (j >> 7) + (j & 127);
    if (MAP == 2) return 256 * (j >> 7) + 128 + (j & 127);
    if (j < 1352) return j;
    if (j < 1864) return 1536 + (j - 1352);
    if (j < 2376) return 2048 + (j - 1864);
    if (j < 2888) return 2560 + (j - 2376);
    if (j < 2892) return 1352 + (j - 2888);
    if (j < 2896) return 1356 + (j - 2892);
    if (j < 3408) return 3072 + (j - 2896);
    if (j < 4432) return 3584 + (j - 3408);
    return 4608 + (j - 4432);
}
template <int MAP> __device__ __forceinline__ void transpose_item(const float* W, int K, int N, h16* WT, LAS float* scr, int item, int lane) {
    const int nblk = (N + 31) / 32, kb = item / nblk, nb = item % nblk, k0 = 64 * kb, n0 = 32 * nb;
    const int ncol = n0 + (lane & 31);
#pragma unroll 8
    for (int i = 0; i < 32; ++i) { const int kk = 2 * i + (lane >> 5); scr[kk * 33 + (lane & 31)] = (ncol < N) ? W[(size_t)(k0 + kk) * N + ncol] : 0.f; }
    asm volatile("s_waitcnt lgkmcnt(0)" ::: "memory");
    const int c = lane & 7;
#pragma unroll
    for (int j = 0; j < 4; ++j) {
        const int n = (lane >> 3) + 8 * j; const LAS float* s = scr + (8 * c) * 33 + n;
        float v[8];
#pragma unroll
        for (int q = 0; q < 8; ++q) v[q] = s[q * 33];
        if (n0 + n < N) *(half8*)(WT + (size_t)wmap<MAP>(n0 + n) * K + k0 + 8 * c) = pack8(v);
    }
    asm volatile("s_waitcnt lgkmcnt(0)" ::: "memory");
}
template <int MAP> __device__ __forceinline__ void transpose_mat(const float* W, int K, int N, h16* WT, LAS float* scr, int gw, int ngw, int lane) {
    const int nitems = (K / 64) * ((N + 31) / 32);
    for (int it = gw; it < nitems; it += ngw) transpose_item<MAP>(W, K, N, WT, scr, it, lane);
}

__device__ __forceinline__ void phase_prologue(const Args& a, LAS unsigned char* lds, int vcu, int G) {
    const int tid = threadIdx.x, lane = tid & 63, wave = __builtin_amdgcn_readfirstlane(tid >> 6);
    unsigned char* ws = a.ws;
    LAS float* scr = (LAS float*)(lds + wave * 16384);
    const int gw = vcu * NWAVES + wave, ngw = G * NWAVES;
    transpose_mat<1>(a.in[5], DM, DFF, (h16*)(ws + WS_W13A), scr, gw, ngw, lane);
    transpose_mat<2>(a.in[6], DM, DFF, (h16*)(ws + WS_W13A), scr, gw, ngw, lane);
    transpose_mat<0>(a.in[7], DFF, DM, (h16*)(ws + WS_W2A), scr, gw, ngw, lane);
    transpose_mat<3>(a.in[9], DM, DIN, (h16*)(ws + WS_WIN), scr, gw, ngw, lane);
    transpose_mat<0>(a.in[18], 512, DM, (h16*)(ws + WS_WBA), scr, gw, ngw, lane);
    transpose_mat<0>(a.in[19], 512, DM, (h16*)(ws + WS_WBM), scr, gw, ngw, lane);
    transpose_mat<0>(a.in[20], DM, DM, (h16*)(ws + WS_WOUT), scr, gw, ngw, lane);
    {
        const float* wuk = a.in[13]; const float* wuv = a.in[14]; h16* ouk = (h16*)(ws + WS_WUK); h16* ouvt = (h16*)(ws + WS_WUVT);
        for (int i = vcu * NTHR + tid; i < 8 * 256 * 64; i += G * NTHR) {
            ouk[i] = (h16)wuk[i];
            const int h = i >> 14, d = (i >> 8) & 63, c = i & 255;
            ouvt[i] = (h16)wuv[(h * 256 + c) * 64 + d];
        }
    }
    {
        const float* cin = a.in[1]; const float* aw = a.in[2]; float* modp = (float*)(ws + WS_MODP);
        for (int it = vcu; it < NKS * 18; it += G) {
            const int ks = it / 18, cb = it % 18, j = cb * 512 + tid;
            float a0 = 0.f, a1 = 0.f;
#pragma unroll 8
            for (int k = ks * 64; k < ks * 64 + 64; ++k) {
                const float w = aw[(size_t)k * 9216 + j];
                a0 += silu_f(cin[k]) * w; a1 += silu_f(cin[DM + k]) * w;
            }
            modp[(size_t)(ks * 2 + 0) * 9216 + j] = a0; modp[(size_t)(ks * 2 + 1) * 9216 + j] = a1;
        }
    }
}

__device__ __forceinline__ void convert_ffn2_weights(const Args& a, LAS unsigned char* lds, int vcu, int G) {
    const int tid = threadIdx.x, lane = tid & 63, wave = __builtin_amdgcn_readfirstlane(tid >> 6);
    LAS float* scr = (LAS float*)(lds + 32768 + wave * 16384);
    const int gw = vcu * NWAVES + wave, ngw = G * NWAVES;
    transpose_mat<1>(a.in[22], DM, DFF, (h16*)(a.ws + WS_W13B), scr, gw, ngw, lane);
    transpose_mat<2>(a.in[23], DM, DFF, (h16*)(a.ws + WS_W13B), scr, gw, ngw, lane);
    transpose_mat<0>(a.in[24], DFF, DM, (h16*)(a.ws + WS_W2B), scr, gw, ngw, lane);
}

template <int MODE> __device__ __forceinline__ void phase_norm(const Args& a, LAS unsigned char* lds, int vcu, int G, const float* xin, const float* gain, int chunk_sh, h16* xn_out, float* f32_out) {
    const int tid = threadIdx.x, lane = tid & 63, wave = __builtin_amdgcn_readfirstlane(tid >> 6);
    LAS float* modL = (LAS float*)lds;
    const float* modp = (const float*)(a.ws + WS_MODP); float* mod = (float*)(a.ws + WS_MOD); const float* adab = a.in[3];
    if (MODE == 0) {
        for (int i = tid; i < 4096; i += NTHR) {
            const int b = i >> 11, which = (i >> 10) & 1, col = i & 1023, j = (chunk_sh + which) * 1024 + col;
            float s = adab[j];
            for (int ks = 0; ks < NKS; ++ks) s += modp[(size_t)(ks * 2 + b) * 9216 + j];
            modL[i] = which ? 1.f + s : s;
        }
        for (int i = vcu * NTHR + tid; i < 2 * 9216; i += G * NTHR) {
            const int b = i / 9216, j = i % 9216;
            float s = adab[j];
            for (int ks = 0; ks < NKS; ++ks) s += modp[(size_t)(ks * 2 + b) * 9216 + j];
            mod[i] = s;
        }
        __syncthreads();
    } else if (MODE == 1) {
        for (int i = tid; i < 4096; i += NTHR) {
            const int b = i >> 11, which = (i >> 10) & 1, col = i & 1023;
            const float s = mod[(size_t)b * 9216 + (chunk_sh + which) * 1024 + col];
            modL[i] = which ? 1.f + s : s;
        }
        __syncthreads();
    }
    const int gw = vcu * NWAVES + wave, ngw = G * NWAVES;
    for (int m = gw; m < MTOK; m += ngw) {
        const pg8::f32x4* xr = (const pg8::f32x4*)(xin + (size_t)m * DM) + lane;
        pg8::f32x4 v[4]; float s = 0.f;
#pragma unroll
        for (int j = 0; j < 4; ++j) { v[j] = xr[64 * j]; s += (v[j].x * v[j].x + v[j].y * v[j].y) + (v[j].z * v[j].z + v[j].w * v[j].w); }
        WAVE_SUM(s);
        const float rstd = 1.0f / sqrtf(s * (1.f / DM) + EPS);
        const int b = m / SEQ;
#pragma unroll
        for (int j = 0; j < 4; ++j) {
            const int col = 4 * lane + 256 * j;
            const pg8::f32x4 g = *(const pg8::f32x4*)(gain + col);
            pg8::f32x4 y = v[j] * rstd * g;
            if (MODE == 2) { *((pg8::f32x4*)(f32_out + (size_t)m * DM) + lane + 64 * j) = y; }
            else {
                const pg8::f32x4 sh = *(const LAS pg8::f32x4*)(modL + (b * 2 + 0) * 1024 + col), sc = *(const LAS pg8::f32x4*)(modL + (b * 2 + 1) * 1024 + col);
                y = y * sc + sh;
                half4 o; o[0] = (h16)y.x; o[1] = (h16)y.y; o[2] = (h16)y.z; o[3] = (h16)y.w;
                *(half4*)(xn_out + (size_t)m * DM + col) = o;
            }
        }
    }
}

__device__ __forceinline__ void kv_finalize(const Args& a, int vcu, int G) {
    const int tid = threadIdx.x, lane = tid & 63, wave = __builtin_amdgcn_readfirstlane(tid >> 6);
    h16* ckv = (h16*)(a.ws + WS_CKV); const float* g = a.in[12];
    const int gw = vcu * NWAVES + wave, ngw = G * NWAVES;
    const pg8::f32x4 gv = *(const pg8::f32x4*)(g + 4 * lane);
    for (int m = gw; m < MTOK; m += ngw) {
        half4 v = *(half4*)(ckv + (size_t)m * 256 + 4 * lane);
        float f0 = (float)v[0], f1 = (float)v[1], f2 = (float)v[2], f3 = (float)v[3];
        float s = (f0 * f0 + f1 * f1) + (f2 * f2 + f3 * f3);
        WAVE_SUM(s);
        const float rstd = 1.0f / sqrtf(s * (1.f / 256.f) + EPS);
        half4 o; o[0] = (h16)(f0 * rstd * gv.x); o[1] = (h16)(f1 * rstd * gv.y); o[2] = (h16)(f2 * rstd * gv.z); o[3] = (h16)(f3 * rstd * gv.w);
        *(half4*)(ckv + (size_t)m * 256 + 4 * lane) = o;
    }
}

__device__ __forceinline__ unsigned f2key(float f) { const unsigned u = __float_as_uint(f); return (u & 0x80000000u) ? ~u : (u | 0x80000000u); }
__device__ __forceinline__ float key2f(unsigned k) { const unsigned u = (k & 0x80000000u) ? (k & 0x7fffffffu) : ~k; return __uint_as_float(u); }
constexpr int CAP = 752;
constexpr int IX_ST = 2 * 9216;
template <int CTRL> __device__ __forceinline__ float dpp_f(float v) { return __builtin_bit_cast(float, __builtin_amdgcn_update_dpp(0, __builtin_bit_cast(int, v), CTRL, 0xF, 0xF, true)); }
__device__ __forceinline__ float xl16_max(float v) {
    auto r = __builtin_amdgcn_permlane16_swap(__float_as_uint(v), __float_as_uint(v), false, false); v = fmaxf(__uint_as_float(r[0]), __uint_as_float(r[1]));
    auto q = __builtin_amdgcn_permlane32_swap(__float_as_uint(v), __float_as_uint(v), false, false); return fmaxf(__uint_as_float(q[0]), __uint_as_float(q[1]));
}
__device__ __forceinline__ float wave_max_fast(float v) {
    v = fmaxf(v, dpp_f<0xB1>(v)); v = fmaxf(v, dpp_f<0x4E>(v)); v = fmaxf(v, dpp_f<0x141>(v)); v = fmaxf(v, dpp_f<0x140>(v)); return xl16_max(v);
}
__device__ __forceinline__ float relu_asm(float x) { const int b = __builtin_bit_cast(int, x); return __builtin_bit_cast(float, b > 0 ? b : 0); }
template <int EPL> __device__ __forceinline__ void select256(LAS float* scB, LAS unsigned short* ixB, int n, int lane) {
    unsigned key[EPL]; unsigned short idv[EPL]; float scv[EPL];
#pragma unroll
    for (int j = 0; j < EPL; ++j) { const int i = lane + 64 * j; const bool ok = i < n; scv[j] = ok ? scB[i] : 0.f; idv[j] = ok ? ixB[i] : (unsigned short)0; key[j] = ok ? f2key(scv[j]) : 0u; }
    unsigned T = 0u;
    for (int bit = 31; bit >= 0; --bit) {
        const unsigned cand = T | (1u << bit); int c = 0;
#pragma unroll
        for (int j = 0; j < EPL; ++j) c += __popcll(__ballot(key[j] >= cand));
        if (c >= TOPK) T = cand;
    }
    int ngt = 0;
#pragma unroll
    for (int j = 0; j < EPL; ++j) ngt += __popcll(__ballot(key[j] > T));
    const int need_eq = TOPK - ngt;
    const unsigned long long lt = (1ull << lane) - 1ull;
    int base = 0, eqbase = 0;
#pragma unroll
    for (int j = 0; j < EPL; ++j) {
        const bool gt = key[j] > T, eq = key[j] == T;
        const unsigned long long meq = __ballot(eq);
        const int eqrank = eqbase + __popcll(meq & lt);
        const bool keep = gt || (eq && eqrank < need_eq);
        const unsigned long long mk = __ballot(keep);
        const int pos = base + __popcll(mk & lt);
        if (keep) { scB[pos] = scv[j]; ixB[pos] = idv[j]; }
        base += __popcll(mk); eqbase += __popcll(meq);
    }
}
__device__ __forceinline__ float prune_approx(LAS float* scB, LAS unsigned short* ixB, int n, float thr_old, int lane, int* newcnt) {
    constexpr int EPL = 12;
    float scv[EPL];
#pragma unroll
    for (int j = 0; j < EPL; ++j) { const int i = lane + 64 * j; scv[j] = (i < n) ? scB[i] : -INFINITY; }
    float mx = scv[0], mn = -scv[0];
#pragma unroll
    for (int j = 1; j < EPL; ++j) { mx = fmaxf(mx, scv[j]); mn = fmaxf(mn, (lane + 64 * j < n) ? -scv[j] : -INFINITY); }
    mx = wave_max_fast(mx); mn = -wave_max_fast(mn);
    float lo = fmaxf(thr_old, mn), hi = mx; int clo = n;
    for (int it = 0; it < 12; ++it) {
        const float mid = 0.5f * lo + 0.5f * hi;
        if (!(mid > lo) || !(mid < hi)) break;
        int c = 0;
#pragma unroll
        for (int j = 0; j < EPL; ++j) c += __popcll(__ballot(scv[j] >= mid));
        if (c >= TOPK) { lo = mid; clo = c; if (c <= TOPK + 48) break; } else hi = mid;
    }
    const unsigned long long lt = (1ull << lane) - 1ull;
    int base = 0;
#pragma unroll
    for (int j = 0; j < EPL; ++j) {
        const bool keep = scv[j] >= lo;
        const unsigned long long mk = __ballot(keep);
        const int pos = base + __popcll(mk & lt);
        const unsigned short iv = (lane + 64 * j < n) ? ixB[lane + 64 * j] : (unsigned short)0;
        if (keep) { scB[pos] = scv[j]; ixB[pos] = iv; }
        base += __popcll(mk);
    }
    *newcnt = clo;
    return lo;
}

__device__ __forceinline__ void indexer_unit(const Args& a, LAS unsigned char* lds, int b, int blk) {
    const int tid = threadIdx.x, lane = tid & 63, wave = __builtin_amdgcn_readfirstlane(tid >> 6);
    const h16* QIDX = (const h16*)(a.ws + WS_QIDX); const h16* KIDX = (const h16*)(a.ws + WS_KIDX); const float* WIDX = (const float*)(a.ws + WS_WIDX);
    unsigned short* SEL = (unsigned short*)(a.ws + WS_SEL);
    const int t0 = blk * 32; const size_t rowb = (size_t)b * SEQ;
    LAS unsigned char* st = lds;
    LAS float* scW = (LAS float*)(lds + IX_ST + wave * (4 * CAP * 6));
    LAS unsigned short* ixW = (LAS unsigned short*)(lds + IX_ST + wave * (4 * CAP * 6) + 4 * CAP * 4);
    volatile LAS unsigned* flag = (volatile LAS unsigned*)(lds + MISC_OFF + 64);
    const int fr = lane & 15, fq = lane >> 4, tw = t0 + 4 * wave, t = tw + fq;
    half8 qa[2][2];
#pragma unroll
    for (int g = 0; g < 2; ++g)
#pragma unroll
        for (int ks = 0; ks < 2; ++ks) qa[g][ks] = *(const half8*)(QIDX + (rowb + tw + (fr >> 2)) * 512 + ((fr & 3) + 4 * g) * 64 + ks * 32 + fq * 8);
    const pg8::f32x4 w0 = *(const pg8::f32x4*)(WIDX + (rowb + t) * 8), w1 = *(const pg8::f32x4*)(WIDX + (rowb + t) * 8 + 4);
    float thr = -INFINITY; int cnt = 0;
    const int nst = t0 / 64 + 1;
    const h16* ksrc = KIDX + (rowb + (tid >> 3)) * 64 + (tid & 7) * 8;
    u32x4 pre = *(const u32x4*)ksrc;
    if (tid < 3) flag[tid] = 0u;
    __syncthreads();
    for (int si = 0; si < nst; ++si) {
        LAS unsigned char* sb = st + (si & 1) * 9216;
        *(LAS u32x4*)(sb + (tid >> 3) * 144 + (tid & 7) * 16) = pre;
        if (__any(cnt > CAP - 64)) { if (lane == 0) flag[si % 3] = 1u; }
        __syncthreads();
        const bool epoch = flag[si % 3] != 0u;
        if (tid == 0) flag[(si + 2) % 3] = 0u;
        if (si + 1 < nst) pre = *(const u32x4*)(ksrc + (size_t)(si + 1) * 64 * 64);
        if (epoch) {
#pragma unroll
            for (int tk = 0; tk < 4; ++tk) {
                const int c = __builtin_amdgcn_readlane(cnt, 16 * tk);
                if (c > TOPK + 64) {
                    int nc; const float thr_old = __builtin_bit_cast(float, __builtin_amdgcn_readlane(__builtin_bit_cast(int, thr), 16 * tk));
                    const float nthr = prune_approx(scW + tk * CAP, ixW + tk * CAP, c, thr_old, lane, &nc);
                    if (nc > CAP - 64) { select256<12>(scW + tk * CAP, ixW + tk * CAP, nc, lane); nc = TOPK; }
                    if (fq == tk) { thr = nthr; cnt = nc; }
                }
            }
        }
        const int s0 = si * 64;
        pg8::f32x4 a0[4], a1[4];
#pragma unroll
        for (int kb = 0; kb < 4; ++kb) {
            const half8 k0 = *(const LAS half8*)(sb + (16 * kb + fr) * 144 + fq * 16), k1 = *(const LAS half8*)(sb + (16 * kb + fr) * 144 + 64 + fq * 16);
            a0[kb] = (pg8::f32x4){0.f, 0.f, 0.f, 0.f}; a1[kb] = (pg8::f32x4){0.f, 0.f, 0.f, 0.f};
            a0[kb] = mfma16(qa[0][0], k0, a0[kb]); a0[kb] = mfma16(qa[0][1], k1, a0[kb]);
            a1[kb] = mfma16(qa[1][0], k0, a1[kb]); a1[kb] = mfma16(qa[1][1], k1, a1[kb]);
        }
#pragma unroll
        for (int kb = 0; kb < 4; ++kb) {
            float sc = 0.f;
            sc = fmaf(w0.x, relu_asm(a0[kb][0]), sc); sc = fmaf(w0.y, relu_asm(a0[kb][1]), sc); sc = fmaf(w0.z, relu_asm(a0[kb][2]), sc); sc = fmaf(w0.w, relu_asm(a0[kb][3]), sc);
            sc = fmaf(w1.x, relu_asm(a1[kb][0]), sc); sc = fmaf(w1.y, relu_asm(a1[kb][1]), sc); sc = fmaf(w1.z, relu_asm(a1[kb][2]), sc); sc = fmaf(w1.w, relu_asm(a1[kb][3]), sc);
            const int s = s0 + 16 * kb + fr;
            const bool pass = (s <= t) && (sc >= thr);
            const unsigned long long mask = __ballot(pass);
            const unsigned fld = (unsigned)(mask >> (16 * fq)) & 0xffffu;
            const int prefix = __popc(fld & ((1u << fr) - 1u));
            if (pass) { const int p = cnt + prefix; scW[fq * CAP + p] = sc; ixW[fq * CAP + p] = (unsigned short)s; }
            cnt += __popc(fld);
        }
    }
#pragma unroll
    for (int tk = 0; tk < 4; ++tk) {
        int c = __builtin_amdgcn_readlane(cnt, 16 * tk);
        if (c > TOPK + 64) {
            int nc; const float thr_old = __builtin_bit_cast(float, __builtin_amdgcn_readlane(__builtin_bit_cast(int, thr), 16 * tk));
            (void)prune_approx(scW + tk * CAP, ixW + tk * CAP, c, thr_old, lane, &nc); c = nc;
        }
        if (c > TOPK) { if (c <= 320) select256<5>(scW + tk * CAP, ixW + tk * CAP, c, lane); else select256<12>(scW + tk * CAP, ixW + tk * CAP, c, lane); c = TOPK; }
#pragma unroll
        for (int i = 0; i < 4; ++i) { const int k = lane + 64 * i; SEL[(rowb + tw + tk) * 256 + k] = (k < c) ? ixW[tk * CAP + k] : (unsigned short)0xFFFF; }
    }
    __syncthreads();
}
__device__ __forceinline__ void phase_indexer(const Args& a, LAS unsigned char* lds, int vcu, int G) {
    for (int p = vcu; p < 256; p += G) { indexer_unit(a, lds, 0, p); indexer_unit(a, lds, 1, 255 - p); }
}

constexpr int SA_QABS = 0, SA_CH = 67584, SA_SELW = SA_CH + 8 * 8704, SA_BIAS = SA_SELW + 8192, SA_END = SA_BIAS + 1024;
static_assert(SA_END <= MISC_OFF, "sparse attention LDS");
typedef short v4i16_t __attribute__((ext_vector_type(4)));
typedef int i32x4 __attribute__((ext_vector_type(4)));
__device__ __forceinline__ half4 tr_read4(const LAS h16* p) { return __builtin_bit_cast(half4, __builtin_amdgcn_ds_read_tr16_b64_v4i16((LAS v4i16_t*)p)); }
__device__ __forceinline__ float xl_max(float v) {
    auto r = __builtin_amdgcn_permlane16_swap(__float_as_uint(v), __float_as_uint(v), false, false);
    v = fmaxf(__uint_as_float(r[0]), __uint_as_float(r[1]));
    auto q = __builtin_amdgcn_permlane32_swap(__float_as_uint(v), __float_as_uint(v), false, false);
    return fmaxf(__uint_as_float(q[0]), __uint_as_float(q[1]));
}
__device__ __forceinline__ float xl_sum(float v) {
    auto r = __builtin_amdgcn_permlane16_swap(__float_as_uint(v), __float_as_uint(v), false, false);
    v = __uint_as_float(r[0]) + __uint_as_float(r[1]);
    auto q = __builtin_amdgcn_permlane32_swap(__float_as_uint(v), __float_as_uint(v), false, false);
    return __uint_as_float(q[0]) + __uint_as_float(q[1]);
}
__device__ __forceinline__ int t5_bucket(int dist) {
    const int n = dist < 0 ? 0 : dist;
    const int lg = 16 + (int)(__log2f((float)(n < 1 ? 1 : n) * 0.0625f) * 5.333333333f);
    return n < 16 ? n : (lg > 31 ? 31 : lg);
}
struct SaState { float m, l; pg8::f32x4 O[16]; };
__device__ __forceinline__ void sattn_chunk(SaState& st, const half8 (&ac)[8], const half8 (&qb)[8], half8 bfrag, int krow_pos, int t, int ch, int nvalid, LAS h16* CH, int fr, int fq) {
    {
        const int lane_ = fq * 16 + fr, rsel = lane_ >> 5, piece = lane_ & 31;
#pragma unroll
        for (int i = 0; i < 8; ++i) *(LAS half8*)(CH + (2 * i + rsel) * 272 + piece * 8) = ac[i];
    }
    pg8::f32x4 S = {0.f, 0.f, 0.f, 0.f};
    {
        const int j = t5_bucket(t - krow_pos) - 8 * fq;
        const unsigned one = 0x3C00u << ((j & 1) * 16);
        u32x4 oh; oh[0] = ((j >> 1) == 0) ? one : 0u; oh[1] = ((j >> 1) == 1) ? one : 0u; oh[2] = ((j >> 1) == 2) ? one : 0u; oh[3] = ((j >> 1) == 3) ? one : 0u;
        S = mfma16(__builtin_bit_cast(half8, oh), bfrag, S);
    }
#pragma unroll
    for (int cs = 0; cs < 8; ++cs) S = mfma16(*(const LAS half8*)(CH + fr * 272 + cs * 32 + fq * 8), qb[cs], S);
    half4 at[8];
#pragma unroll
    for (int cb = 0; cb < 8; ++cb) at[cb] = tr_read4(CH + (4 * fq + (fr >> 2)) * 272 + cb * 16 + 4 * (fr & 3));
    float sv[4];
#pragma unroll
    for (int r = 0; r < 4; ++r) sv[r] = (ch * 16 + 4 * fq + r < nvalid) ? S[r] : -INFINITY;
    const float cmax = xl_max(fmaxf(fmaxf(sv[0], sv[1]), fmaxf(sv[2], sv[3])));
    const float mn = fmaxf(st.m, cmax);
    if (__any(mn > st.m)) {
        const float sc = __expf(st.m - mn);
        st.l *= sc;
#pragma unroll
        for (int cb = 0; cb < 16; ++cb) st.O[cb] *= sc;
    }
    st.m = mn;
    half4 pf; float ps = 0.f;
#pragma unroll
    for (int r = 0; r < 4; ++r) { const float p = __expf(sv[r] - mn); ps += p; pf[r] = (h16)p; }
    st.l += ps;
#pragma unroll
    for (int cb = 0; cb < 8; ++cb) st.O[cb] = __builtin_amdgcn_mfma_f32_16x16x16f16(at[cb], pf, st.O[cb], 0, 0, 0);
#pragma unroll
    for (int cb = 0; cb < 8; ++cb) at[cb] = tr_read4(CH + (4 * fq + (fr >> 2)) * 272 + (cb + 8) * 16 + 4 * (fr & 3));
#pragma unroll
    for (int cb = 0; cb < 8; ++cb) st.O[cb + 8] = __builtin_amdgcn_mfma_f32_16x16x16f16(at[cb], pf, st.O[cb + 8], 0, 0, 0);
}
__device__ __forceinline__ void sattn_unit(const Args& a, LAS unsigned char* lds, int unit) {
    const int tid = threadIdx.x, lane = tid & 63, wave = __builtin_amdgcn_readfirstlane(tid >> 6);
    const int fr = lane & 15, fq = lane >> 4;
    const h16* QA = (const h16*)(a.ws + WS_QA); const h16* CKV = (const h16*)(a.ws + WS_CKV); const h16* WUK = (const h16*)(a.ws + WS_WUK); const h16* WUVT = (const h16*)(a.ws + WS_WUVT);
    const unsigned short* SEL = (const unsigned short*)(a.ws + WS_SEL); h16* YA = (h16*)(a.ws + WS_YA);
    LAS h16* QABS = (LAS h16*)(lds + SA_QABS); LAS h16* CH = (LAS h16*)(lds + SA_CH + wave * 8704); LAS int* SELW = (LAS int*)(lds + SA_SELW) + wave * 256;
    LAS float* BIAS = (LAS float*)(lds + SA_BIAS);
    const int row0 = unit * 16, b = row0 / SEQ, tpos0 = row0 - b * SEQ;
    const size_t rowb = (size_t)b * SEQ;
    half8 bfrag;
#pragma unroll
    for (int j = 0; j < 8; ++j) bfrag[j] = (h16)BIAS[(8 * fq + j) * 8 + (fr & 7)];
    {
        const int h = wave;
        half8 af[2];
#pragma unroll
        for (int ks = 0; ks < 2; ++ks) af[ks] = *(const half8*)(QA + (size_t)(row0 + fr) * 512 + h * 64 + ks * 32 + fq * 8);
#pragma unroll 8
        for (int cb = 0; cb < 16; ++cb) {
            pg8::f32x4 acc = {0.f, 0.f, 0.f, 0.f};
#pragma unroll
            for (int ks = 0; ks < 2; ++ks) acc = mfma16(af[ks], *(const half8*)(WUK + (size_t)(h * 256 + cb * 16 + fr) * 64 + ks * 32 + fq * 8), acc);
#pragma unroll
            for (int r = 0; r < 4; ++r) QABS[((4 * fq + r) * 8 + h) * 264 + cb * 16 + fr] = (h16)(acc[r] * 0.125f);
        }
    }
    __syncthreads();
#pragma unroll 1
    for (int tt = 0; tt < 2; ++tt) {
        const int tl = 2 * wave + tt, t = tpos0 + tl, row = row0 + tl;
#pragma unroll
        for (int i = 0; i < 4; ++i) SELW[lane + 64 * i] = (int)SEL[(size_t)row * 256 + lane + 64 * i];
        const int nvalid = (t + 1 < TOPK) ? t + 1 : TOPK;
        half8 qb[8];
#pragma unroll
        for (int cs = 0; cs < 8; ++cs) qb[cs] = *(const LAS half8*)(QABS + (tl * 8 + (fr & 7)) * 264 + cs * 32 + fq * 8);
        SaState st; st.m = -INFINITY; st.l = 0.f;
#pragma unroll
        for (int cb = 0; cb < 16; ++cb) st.O[cb] = (pg8::f32x4){0.f, 0.f, 0.f, 0.f};
        half8 fa[8], fb[8];
        int kpa, kpb;
#define SA_LOAD(dst, kp, ch) do { const int k_ = SELW[(ch) * 16 + fr]; kp = (k_ != 0xFFFF) ? k_ : 0; \
            _Pragma("unroll") for (int i_ = 0; i_ < 8; ++i_) { int r_ = SELW[(ch) * 16 + 2 * i_ + (lane >> 5)]; r_ = (r_ != 0xFFFF) ? r_ : 0; dst[i_] = *(const half8*)(CKV + (rowb + r_) * 256 + (lane & 31) * 8); } } while (0)
        SA_LOAD(fa, kpa, 0);
#pragma unroll 1
        for (int ch = 0; ch < 16; ch += 2) {
            SA_LOAD(fb, kpb, ch + 1);
            sattn_chunk(st, fa, qb, bfrag, kpa, t, ch, nvalid, CH, fr, fq);
            if (ch + 2 < 16) SA_LOAD(fa, kpa, ch + 2);
            sattn_chunk(st, fb, qb, bfrag, kpb, t, ch + 1, nvalid, CH, fr, fq);
        }
#undef SA_LOAD
        const float inv = 1.f / xl_sum(st.l);
        if (fr < 8) {
#pragma unroll
            for (int cb = 0; cb < 16; ++cb) {
                half4 ov; ov[0] = (h16)(st.O[cb][0] * inv); ov[1] = (h16)(st.O[cb][1] * inv); ov[2] = (h16)(st.O[cb][2] * inv); ov[3] = (h16)(st.O[cb][3] * inv);
                *(LAS half4*)(QABS + (tl * 8 + fr) * 264 + cb * 16 + 4 * fq) = ov;
            }
        }
    }
    __syncthreads();
    {
        const int h = wave;
#pragma unroll
        for (int db = 0; db < 4; ++db) {
            pg8::f32x4 acc = {0.f, 0.f, 0.f, 0.f};
#pragma unroll
            for (int cs = 0; cs < 8; ++cs) acc = mfma16(*(const LAS half8*)(QABS + (fr * 8 + h) * 264 + cs * 32 + fq * 8), *(const half8*)(WUVT + (size_t)(h * 64 + db * 16 + fr) * 256 + cs * 32 + fq * 8), acc);
#pragma unroll
            for (int r = 0; r < 4; ++r) YA[(size_t)(row0 + 4 * fq + r) * 512 + h * 64 + db * 16 + fr] = (h16)acc[r];
        }
    }
    __syncthreads();
}
__device__ __forceinline__ void phase_sattn(const Args& a, LAS unsigned char* lds, int vcu, int G) {
    const int tid = threadIdx.x;
    LAS float* BIAS = (LAS float*)(lds + SA_BIAS);
    if (tid < 256) BIAS[tid] = a.in[17][tid];
    __syncthreads();
    if (G == 256) {
        const int j = vcu >> 5, w = vcu & 31;
        for (int i = 0; i < 4; ++i) sattn_unit(a, lds, (j >> 2) * 512 + (j & 3) * 128 + i * 32 + w);
    } else {
        for (int u = vcu; u < MTOK / 16; u += G) sattn_unit(a, lds, u);
    }
}

__device__ __forceinline__ void mlstmA_unit(const Args& a, LAS unsigned char* lds, int u) {
    const int tid = threadIdx.x, lane = tid & 63, wave = __builtin_amdgcn_readfirstlane(tid >> 6);
    const int fr = lane & 15, fq = lane >> 4;
    const int bh = u >> 7, j = u & 127, b = bh >> 2, h = bh & 3, tpos0 = j * 64; const size_t rowb = (size_t)b * SEQ, r0 = rowb + tpos0;
    const h16* QM = (const h16*)(a.ws + WS_QM); const h16* KM = (const h16*)(a.ws + WS_KM); const h16* VM = (const h16*)(a.ws + WS_VM);
    const float* GI = (const float*)(a.ws + WS_GI); const float* GF = (const float*)(a.ws + WS_GF);
    h16* Q2 = (h16*)(a.ws + WS_Q2); h16* K2 = (h16*)(a.ws + WS_K2); h16* UT = (h16*)(a.ws + WS_UT);
    float* NVEC = (float*)(a.ws + WS_NVEC); float* MLOC = (float*)(a.ws + WS_MLOC); float* BLAST = (float*)(a.ws + WS_BLAST);
    const float* convw = a.in[10]; const float* convb = a.in[11];
    LAS h16* KWT = (LAS h16*)lds; LAS h16* VT = (LAS h16*)(lds + 18432); LAS float* wL = (LAS float*)(lds + 36864);
    if (tid < 64) {
        const int s = tid;
        const float lf = GF[(r0 + s) * 4 + h], ig = GI[(r0 + s) * 4 + h];
        float bs = lf;
#pragma unroll
        for (int off = 1; off < 64; off <<= 1) { const float v = __shfl_up(bs, off); if (lane >= off) bs += v; }
        const float bl = __shfl(bs, 63);
        const float g = bl - bs + ig;
        float ml = g; WAVE_MAX(ml);
        wL[s] = __expf(g - ml);
        if (tid == 0) { MLOC[u] = ml; BLAST[u] = bl; }
    }
    __syncthreads();
#pragma unroll 1
    for (int it = 0; it < 2; ++it) {
        const int p = tid + NTHR * it, s = p >> 4, cg = p & 15, colh = h * 128 + cg * 8;
#pragma unroll
        for (int tz = 0; tz < 2; ++tz) {
            const h16* src = tz ? KM : QM; const int ccol = tz * 512 + colh;
            float acc[8];
#pragma unroll
            for (int i = 0; i < 8; ++i) acc[i] = convb[ccol + i];
#pragma unroll
            for (int w = 0; w < 4; ++w) {
                const int tp = tpos0 + s - 3 + w;
                if (tp >= 0) {
                    const half8 x = *(const half8*)(src + (rowb + tp) * 512 + colh);
#pragma unroll
                    for (int i = 0; i < 8; ++i) acc[i] += convw[w * 1024 + ccol + i] * (float)x[i];
                }
            }
            if (tz == 0) {
#pragma unroll
                for (int i = 0; i < 8; ++i) acc[i] = silu_f(acc[i]);
                *(half8*)(Q2 + (r0 + s) * 512 + colh) = pack8(acc);
            } else {
                const float ws_ = wL[s];
#pragma unroll
                for (int i = 0; i < 8; ++i) acc[i] = silu_f(acc[i]) * 0.08838834764831845f;
                *(half8*)(K2 + (r0 + s) * 512 + colh) = pack8(acc);
#pragma unroll
                for (int i = 0; i < 8; ++i) KWT[(cg * 8 + i) * 72 + s] = (h16)(acc[i] * ws_);
            }
        }
        const half8 v = *(const half8*)(VM + (r0 + s) * 512 + colh);
#pragma unroll
        for (int i = 0; i < 8; ++i) VT[(cg * 8 + i) * 72 + s] = v[i];
    }
    __syncthreads();
    if (tid < 128) {
        float sum = 0.f;
        for (int s = 0; s < 64; ++s) sum += (float)KWT[tid * 72 + s];
        NVEC[(size_t)u * 128 + tid] = sum;
    }
#pragma unroll 2
    for (int db = 0; db < 8; ++db) {
        pg8::f32x4 acc = {0.f, 0.f, 0.f, 0.f};
#pragma unroll
        for (int ks = 0; ks < 2; ++ks) acc = mfma16(*(const LAS half8*)(VT + (wave * 16 + fr) * 72 + ks * 32 + fq * 8), *(const LAS half8*)(KWT + (db * 16 + fr) * 72 + ks * 32 + fq * 8), acc);
#pragma unroll
        for (int r = 0; r < 4; ++r) UT[(size_t)u * 16384 + (wave * 16 + 4 * fq + r) * 128 + db * 16 + fr] = (h16)acc[r];
    }
    __syncthreads();
}

__device__ __forceinline__ void phase_mlstmB(const Args& a, LAS unsigned char* lds, int vcu, int G) {
    const int tid = threadIdx.x;
    const float* MLOC = (const float*)(a.ws + WS_MLOC); const float* BLAST = (const float*)(a.ws + WS_BLAST); const float* NVEC = (const float*)(a.ws + WS_NVEC);
    const h16* UT = (const h16*)(a.ws + WS_UT); h16* CT = (h16*)(a.ws + WS_CT); float* NST = (float*)(a.ws + WS_NST); float* MST = (float*)(a.ws + WS_MST);
    LAS float* decL = (LAS float*)lds; LAS float* sclL = decL + 1024; LAS float* mL = sclL + 1024; LAS float* blL = mL + 1024; LAS float* mlL = blL + 1024;
    for (int i = tid; i < 1024; i += NTHR) { blL[i] = BLAST[i]; mlL[i] = MLOC[i]; }
    __syncthreads();
    if (tid < 8) {
        float m = 0.f;
        for (int j = 0; j < 128; ++j) {
            const float bl = blL[tid * 128 + j], ml = mlL[tid * 128 + j];
            mL[tid * 128 + j] = m;
            const float mn = fmaxf(bl + m, ml);
            decL[tid * 128 + j] = __expf(bl + m - mn); sclL[tid * 128 + j] = __expf(ml - mn); m = mn;
        }
    }
    __syncthreads();
    for (int idx = vcu * NTHR + tid; idx < 8 * 16384; idx += G * NTHR) {
        const int bh = idx >> 14, el = idx & 16383;
        float C = 0.f;
#pragma unroll 8
        for (int j = 0; j < 128; ++j) {
            const size_t off = (size_t)(bh * 128 + j) * 16384 + el;
            CT[off] = (h16)C;
            C = decL[bh * 128 + j] * C + sclL[bh * 128 + j] * (float)UT[off];
        }
    }
    for (int idx = vcu * NTHR + tid; idx < 8 * 128; idx += G * NTHR) {
        const int bh = idx >> 7, d = idx & 127;
        float n = 0.f;
        for (int j = 0; j < 128; ++j) {
            NST[(size_t)(bh * 128 + j) * 128 + d] = n;
            n = decL[bh * 128 + j] * n + sclL[bh * 128 + j] * NVEC[(size_t)(bh * 128 + j) * 128 + d];
            if (d == 0) MST[bh * 128 + j] = mL[bh * 128 + j];
        }
    }
}

constexpr int MC_QL = 0, MC_KL = 17408, MC_VT = 34816, MC_CTL = 53248, MC_PL = 88064, MC_HL = 97280, MC_SM = 131072;
__device__ __forceinline__ void mlstmC_unit(const Args& a, LAS unsigned char* lds, int u) {
    const int tid = threadIdx.x, lane = tid & 63, wave = __builtin_amdgcn_readfirstlane(tid >> 6);
    const int fr = lane & 15, fq = lane >> 4;
    const int bh = u >> 7, j_ = u & 127, b = bh >> 2, h = bh & 3; const size_t r0 = (size_t)b * SEQ + j_ * 64;
    const h16* Q2 = (const h16*)(a.ws + WS_Q2); const h16* K2 = (const h16*)(a.ws + WS_K2); const h16* VM = (const h16*)(a.ws + WS_VM); const h16* CT = (const h16*)(a.ws + WS_CT);
    const float* GI = (const float*)(a.ws + WS_GI); const float* GF = (const float*)(a.ws + WS_GF); const float* NST = (const float*)(a.ws + WS_NST); const float* MST = (const float*)(a.ws + WS_MST);
    const h16* OG = (const h16*)(a.ws + WS_OG); h16* HM = (h16*)(a.ws + WS_HM); const float* hnorm = a.in[16];
    LAS h16* QL = (LAS h16*)(lds + MC_QL); LAS h16* KL = (LAS h16*)(lds + MC_KL); LAS h16* VT = (LAS h16*)(lds + MC_VT); LAS h16* CTL = (LAS h16*)(lds + MC_CTL);
    LAS h16* PL = (LAS h16*)(lds + MC_PL); LAS float* HL = (LAS float*)(lds + MC_HL);
    LAS float* bL = (LAS float*)(lds + MC_SM); LAS float* aL = bL + 64; LAS float* mjL = bL + 128; LAS float* wiL = bL + 192; LAS float* denL = bL + 256; LAS float* nL = bL + 320;
#pragma unroll 1
    for (int it = 0; it < 2; ++it) {
        const int p = tid + NTHR * it, s = p >> 4, cg = p & 15, colh = h * 128 + cg * 8;
        *(LAS half8*)(QL + s * 136 + cg * 8) = *(const half8*)(Q2 + (r0 + s) * 512 + colh);
        *(LAS half8*)(KL + s * 136 + cg * 8) = *(const half8*)(K2 + (r0 + s) * 512 + colh);
        const half8 v = *(const half8*)(VM + (r0 + s) * 512 + colh);
#pragma unroll
        for (int i = 0; i < 8; ++i) VT[(cg * 8 + i) * 72 + s] = v[i];
    }
#pragma unroll 1
    for (int it = 0; it < 4; ++it) {
        const int p = tid + NTHR * it, e = p >> 4, cg = p & 15;
        *(LAS half8*)(CTL + e * 136 + cg * 8) = *(const half8*)(CT + (size_t)u * 16384 + e * 128 + cg * 8);
    }
    if (tid >= 64 && tid < 192) nL[tid - 64] = NST[(size_t)u * 128 + tid - 64];
    if (tid < 64) {
        const int s = tid;
        const float lf = GF[(r0 + s) * 4 + h], ig = GI[(r0 + s) * 4 + h];
        float bs = lf;
#pragma unroll
        for (int off = 1; off < 64; off <<= 1) { const float v = __shfl_up(bs, off); if (lane >= off) bs += v; }
        const float av = ig - bs;
        float cm = av;
#pragma unroll
        for (int off = 1; off < 64; off <<= 1) { const float v = __shfl_up(cm, off); if (lane >= off) cm = fmaxf(cm, v); }
        const float mp = MST[u];
        const float mj = bs + fmaxf(mp, cm);
        bL[s] = bs; aL[s] = av; mjL[s] = mj; wiL[s] = __expf(bs + mp - mj);
    }
    __syncthreads();
    {
        const int jb = wave >> 1;
#pragma unroll
        for (int q2 = 0; q2 < 2; ++q2) {
            const int sb = (wave & 1) * 2 + q2;
            pg8::f32x4 acc = {0.f, 0.f, 0.f, 0.f};
            if (sb <= jb) {
#pragma unroll
                for (int ks = 0; ks < 4; ++ks) acc = mfma16(*(const LAS half8*)(QL + (jb * 16 + fr) * 136 + ks * 32 + fq * 8), *(const LAS half8*)(KL + (sb * 16 + fr) * 136 + ks * 32 + fq * 8), acc);
            }
            const int s = sb * 16 + fr; const float as_ = aL[s];
#pragma unroll
            for (int r = 0; r < 4; ++r) {
                const int jj = jb * 16 + 4 * fq + r;
                const float pv = (s <= jj) ? acc[r] * __expf(bL[jj] - mjL[jj] + as_) : 0.f;
                PL[jj * 72 + s] = (h16)pv;
            }
        }
    }
    __syncthreads();
    {
        const int jb = wave >> 1;
#pragma unroll 1
        for (int e4 = 0; e4 < 4; ++e4) {
            const int eb = (wave & 1) * 4 + e4;
            pg8::f32x4 a1 = {0.f, 0.f, 0.f, 0.f}, a2 = {0.f, 0.f, 0.f, 0.f};
#pragma unroll
            for (int ks = 0; ks < 4; ++ks) a1 = mfma16(*(const LAS half8*)(QL + (jb * 16 + fr) * 136 + ks * 32 + fq * 8), *(const LAS half8*)(CTL + (eb * 16 + fr) * 136 + ks * 32 + fq * 8), a1);
#pragma unroll
            for (int ks = 0; ks < 2; ++ks) a2 = mfma16(*(const LAS half8*)(PL + (jb * 16 + fr) * 72 + ks * 32 + fq * 8), *(const LAS half8*)(VT + (eb * 16 + fr) * 72 + ks * 32 + fq * 8), a2);
#pragma unroll
            for (int r = 0; r < 4; ++r) { const int jj = jb * 16 + 4 * fq + r; HL[jj * 132 + eb * 16 + fr] = wiL[jj] * a1[r] + a2[r]; }
        }
        const int jj = tid >> 3, part = tid & 7;
        float qn = 0.f, ps = 0.f;
#pragma unroll
        for (int d = 0; d < 16; ++d) qn += (float)QL[jj * 136 + part * 16 + d] * nL[part * 16 + d];
#pragma unroll
        for (int s = 0; s < 8; ++s) ps += (float)PL[jj * 72 + part * 8 + s];
        qn += __shfl_xor(qn, 1); qn += __shfl_xor(qn, 2); qn += __shfl_xor(qn, 4);
        ps += __shfl_xor(ps, 1); ps += __shfl_xor(ps, 2); ps += __shfl_xor(ps, 4);
        if (part == 0) denL[jj] = wiL[jj] * qn + ps;
    }
    __syncthreads();
#pragma unroll 1
    for (int rr = 0; rr < 8; ++rr) {
        const int jj = wave * 8 + rr;
        const float dn = fmaxf(fabsf(denL[jj]), __expf(-mjL[jj]));
        const float h0 = HL[jj * 132 + lane] / dn, h1 = HL[jj * 132 + 64 + lane] / dn;
        float sm = h0 + h1; WAVE_SUM(sm);
        const float mean = sm * (1.f / 128.f), d0 = h0 - mean, d1 = h1 - mean;
        float vs = d0 * d0 + d1 * d1; WAVE_SUM(vs);
        const float rs = 1.0f / sqrtf(vs * (1.f / 128.f) + EPS);
        const size_t o = (r0 + jj) * 512 + h * 128;
        HM[o + lane] = (h16)(d0 * rs * hnorm[h * 128 + lane] * (float)OG[o + lane]);
        HM[o + 64 + lane] = (h16)(d1 * rs * hnorm[h * 128 + 64 + lane] * (float)OG[o + 64 + lane]);
    }
    __syncthreads();
}

#ifndef MK_SPLIT
#define MK_SPLIT 0
#endif
constexpr int NPHASE = 15;
__global__ void __launch_bounds__(NTHR, 2) hybrid_fwd(Args args) {
    extern __shared__ __attribute__((aligned(16))) unsigned char lds_raw[];
    LAS unsigned char* lds = (LAS unsigned char*)lds_raw;
    const int tid = threadIdx.x;
    const int G = gridDim.x; const int bx = blockIdx.x; const int vcu = (G % 8 == 0) ? (bx % 8) * (G / 8) + bx / 8 : bx;
    volatile LAS unsigned* MISC = (volatile LAS unsigned*)(lds + MISC_OFF);
    if (tid < 64) ((LAS unsigned*)(lds + MISC_OFF))[tid] = 0u;
    __syncthreads();
    unsigned char* ws = args.ws;
    gu32* ctl = (gu32*)(ws + WS_CTL);
    XcdBarrier bar; bar.bar = (unsigned*)(ctl + CW_BAR); bar.x = 0; bar.st = nullptr;
    if (!MK_SPLIT) bar = xcd_barrier_post((unsigned*)(ctl + CW_BAR), MISC + 8);
    const int lo = args.ph_lo, hi = args.ph_hi;
#define IN(k) (lo <= (k) && (k) < hi)
#define SEAM(k) do { if (IN(k) && IN((k) + 1)) xcd_barrier(bar); } while (0)
    float* xres = args.out;
    const float* MOD = (const float*)(ws + WS_MOD);
    h16* XN = (h16*)(ws + WS_XN); h16* HID = (h16*)(ws + WS_HID);

    if (IN(0)) { phase_prologue(args, lds, vcu, G); } SEAM(0);
    if (IN(1)) { phase_norm<0>(args, lds, vcu, G, args.in[0], args.in[4], 0, XN, nullptr); } SEAM(1);
    if (IN(2)) {
        pg8::Gemm g{(const pg8::bf16_t*)XN, (const pg8::bf16_t*)(ws + WS_W13A), MTOK, 2 * DFF, DM}; pg8::StaticOrder S; S.init(MTOK, 2 * DFF, G, bx);
        EpiSwiGLU E{HID};
        pg8::gemm_phase<EpiSwiGLU, pg8::StaticOrder, true, true>(lds, g, S, E);
    } SEAM(2);
    if (IN(3)) {
        pg8::Gemm g{(const pg8::bf16_t*)HID, (const pg8::bf16_t*)(ws + WS_W2A), MTOK, DM, DFF}; pg8::StaticOrder S; S.init(MTOK, DM, G, bx);
        EpiResid E{args.in[0], xres, MOD + 2 * 1024, 0.5f};
        pg8::gemm_phase<EpiResid, pg8::StaticOrder, true, true>(lds, g, S, E);
    } SEAM(3);
    if (IN(4)) { phase_norm<1>(args, lds, vcu, G, xres, args.in[8], 3, XN, nullptr); } SEAM(4);
    if (IN(5)) {
        pg8::Gemm g{(const pg8::bf16_t*)XN, (const pg8::bf16_t*)(ws + WS_WIN), MTOK, NWIN, DM}; pg8::StaticOrder S; S.init(MTOK, NWIN, G, bx);
        EpiWin E{ws, args.in[15]};
        pg8::gemm_phase<EpiWin, pg8::StaticOrder, true, true>(lds, g, S, E);
    } SEAM(5);
    if (IN(6)) {
        kv_finalize(args, vcu, G);
        phase_indexer(args, lds, vcu, G);
        for (int u = vcu; u < 1024; u += G) mlstmA_unit(args, lds, u);
    } SEAM(6);
    if (IN(7)) {
        phase_sattn(args, lds, vcu, G);
        phase_mlstmB(args, lds, vcu, G);
    } SEAM(7);
    if (IN(8)) { for (int u = vcu; u < 1024; u += G) mlstmC_unit(args, lds, u); } SEAM(8);
    if (IN(9)) {
        pg8::StaticOrder S; S.init(MTOK, DM, G, bx);
        { pg8::Gemm g{(const pg8::bf16_t*)(ws + WS_YA), (const pg8::bf16_t*)(ws + WS_WBA), MTOK, DM, 512};
          EpiMerge<false> E{(const h16*)(ws + WS_GA), (h16*)(ws + WS_MRG)};
          pg8::gemm_phase<EpiMerge<false>, pg8::StaticOrder, true, true>(lds, g, S, E); }
        __syncthreads();
        { pg8::Gemm g{(const pg8::bf16_t*)(ws + WS_HM), (const pg8::bf16_t*)(ws + WS_WBM), MTOK, DM, 512};
          EpiMerge<true> E{(const h16*)(ws + WS_GM), (h16*)(ws + WS_MRG)};
          pg8::gemm_phase<EpiMerge<true>, pg8::StaticOrder, true, true>(lds, g, S, E); }
    } SEAM(9);
    if (IN(10)) {
        pg8::Gemm g{(const pg8::bf16_t*)(ws + WS_MRG), (const pg8::bf16_t*)(ws + WS_WOUT), MTOK, DM, DM}; pg8::StaticOrder S; S.init(MTOK, DM, G, bx);
        EpiResid E{xres, xres, MOD + 5 * 1024, 1.0f};
        pg8::gemm_phase<EpiResid, pg8::StaticOrder, true, true>(lds, g, S, E);
    } SEAM(10);
    if (IN(11)) { phase_norm<1>(args, lds, vcu, G, xres, args.in[21], 6, XN, nullptr); convert_ffn2_weights(args, lds, vcu, G); } SEAM(11);
    if (IN(12)) {
        pg8::Gemm g{(const pg8::bf16_t*)XN, (const pg8::bf16_t*)(ws + WS_W13B), MTOK, 2 * DFF, DM}; pg8::StaticOrder S; S.init(MTOK, 2 * DFF, G, bx);
        EpiSwiGLU E{HID};
        pg8::gemm_phase<EpiSwiGLU, pg8::StaticOrder, true, true>(lds, g, S, E);
    } SEAM(12);
    if (IN(13)) {
        pg8::Gemm g{(const pg8::bf16_t*)HID, (const pg8::bf16_t*)(ws + WS_W2B), MTOK, DM, DFF}; pg8::StaticOrder S; S.init(MTOK, DM, G, bx);
        EpiResid E{xres, xres, MOD + 8 * 1024, 0.5f};
        pg8::gemm_phase<EpiResid, pg8::StaticOrder, true, true>(lds, g, S, E);
    } SEAM(13);
    if (IN(14)) { phase_norm<2>(args, lds, vcu, G, xres, args.in[25], 0, nullptr, xres); }
#undef IN
#undef SEAM
}

extern "C" void kernel_launch(void* const* d_in, const int* in_sizes, int n_in, void* d_out, int out_size, void* d_ws, size_t ws_size, hipStream_t stream) {
    static int grid = 0;
    if (grid == 0) {
        if (n_in != 26 || out_size != MTOK * DM || ws_size < WS_END) { fprintf(stderr, "kernel_launch: unexpected shapes (n_in %d out %d ws %zu)\n", n_in, out_size, ws_size); grid = -1; return; }
        int dev = 0, cus = 0, per_cu = 0;
        if (hipGetDevice(&dev) != hipSuccess || hipDeviceGetAttribute(&cus, hipDeviceAttributeMultiprocessorCount, dev) != hipSuccess) { grid = -1; return; }
        if (hipFuncSetAttribute((const void*)hybrid_fwd, hipFuncAttributeMaxDynamicSharedMemorySize, LDS_BYTES) != hipSuccess) { fprintf(stderr, "kernel_launch: hipFuncSetAttribute failed\n"); grid = -1; return; }
        if (hipOccupancyMaxActiveBlocksPerMultiprocessor(&per_cu, (const void*)hybrid_fwd, NTHR, LDS_BYTES) != hipSuccess || per_cu < 1) { fprintf(stderr, "kernel_launch: occupancy query says %d blocks per CU\n", per_cu); per_cu = 1; }
        (void)hipGetLastError();
        grid = cus;
    }
    if (grid < 0) return;
    (void)hipMemsetAsync((char*)d_ws + WS_CTL, 0, CTL_ZERO_BYTES, stream);
    Args a{};
    for (int i = 0; i < 26; ++i) a.in[i] = (const float*)d_in[i];
    a.out = (float*)d_out; a.ws = (unsigned char*)d_ws;
#if MK_SPLIT
    for (int p = 0; p < NPHASE; ++p) { a.ph_lo = p; a.ph_hi = p + 1; hipLaunchKernelGGL(hybrid_fwd, dim3(grid), dim3(NTHR), LDS_BYTES, stream, a); }
#else
    a.ph_lo = 0; a.ph_hi = NPHASE;
    hipLaunchKernelGGL(hybrid_fwd, dim3(grid), dim3(NTHR), LDS_BYTES, stream, a);
#endif
}
```
